# Optimizing an MI355X kernel written in HIP

```python
import math
import jax, jax.numpy as jnp
from jax import lax
import numpy as np

D_MODEL = 2048
BATCH = 2
SEQ = 16384
DEPTH = 1
DEC_BATCH = 1
DEC_SEQ = 8192
PAST_LEN = 128

HEAD_DIM = 128
A_HEADS = 6
A_KV_HEADS = 2
A_GROUP = A_HEADS // A_KV_HEADS
WINDOW = 128
BLOCK = 128
N_BUCKETS = 32
MAX_DISTANCE = 128
B_HEADS = 6
Q_LORA = 512
KV_LORA = 512
QK_NOPE = 128
QK_ROPE = 64
V_DIM = 128
ROPE_THETA = 10000.0
Q_BLOCK = 128
C_HEADS = 4
N_MEM = 256
N_BRANCH = 3
D_FF = -(-8 * D_MODEL // (3 * 256)) * 256
ALPHA = (2 * DEPTH) ** 0.25
BETA = (8 * DEPTH) ** -0.25
LN_EPS = 1e-5
RMS_EPS = 1e-6
NEG = -1e30
IN_WIDTHS = (A_HEADS * HEAD_DIM, A_KV_HEADS * HEAD_DIM, A_KV_HEADS * HEAD_DIM, Q_LORA, KV_LORA, QK_ROPE, C_HEADS * HEAD_DIM)
D_IN = sum(IN_WIDTHS)

kernel_name = "hybrid_gated_window_mla_memxattn_encoder"


def layer_norm(x, g, b):
    xf = x.astype(jnp.float32)
    mu = jnp.mean(xf, axis=-1, keepdims=True)
    var = jnp.mean(jnp.square(xf - mu), axis=-1, keepdims=True)
    return ((xf - mu) * lax.rsqrt(var + LN_EPS) * g.astype(jnp.float32) + b.astype(jnp.float32)).astype(x.dtype)


def rms_norm(x, g):
    xf = x.astype(jnp.float32)
    ms = jnp.mean(jnp.square(xf), axis=-1, keepdims=True)
    return (xf * lax.rsqrt(ms + RMS_EPS) * g.astype(jnp.float32)).astype(x.dtype)


def rope_tables(S):
    half = QK_ROPE // 2
    inv = 1.0 / (ROPE_THETA ** (jnp.arange(half, dtype=jnp.float32) / half))
    ang = jnp.arange(S, dtype=jnp.float32)[:, None] * inv[None, :]
    return jnp.cos(ang), jnp.sin(ang)


def apply_rope(x, cos, sin):
    half = QK_ROPE // 2
    xf = x.astype(jnp.float32)
    x1, x2 = xf[..., :half], xf[..., half:]
    return jnp.concatenate([x1 * cos - x2 * sin, x2 * cos + x1 * sin], axis=-1).astype(x.dtype)


def t5_bucket(rel):
    half = N_BUCKETS // 2
    max_exact = half // 2
    ret = (rel > 0).astype(jnp.int32) * half
    n = jnp.abs(rel)
    large = max_exact + (jnp.log(jnp.maximum(n, 1).astype(jnp.float32) / max_exact)
                         / math.log(MAX_DISTANCE / max_exact) * (half - max_exact)).astype(jnp.int32)
    large = jnp.minimum(large, half - 1)
    return ret + jnp.where(n < max_exact, n, large)


def window_gqa(q, k, v, rel_bias, sink):
    B, S = q.shape[0], q.shape[1]
    nb = S // BLOCK
    qb = q.reshape(B, nb, BLOCK, A_KV_HEADS, A_GROUP, HEAD_DIM)

    def neighbours(t):
        t = t.reshape(B, nb, BLOCK, A_KV_HEADS, HEAD_DIM)
        tp = jnp.pad(t, ((0, 0), (1, 1), (0, 0), (0, 0), (0, 0)))
        return jnp.concatenate([tp[:, :-2], tp[:, 1:-1], tp[:, 2:]], axis=2)

    kw, vw = neighbours(k), neighbours(v)
    rel = (jnp.arange(3 * BLOCK) - BLOCK)[None, :] - jnp.arange(BLOCK)[:, None]
    band = jnp.abs(rel) <= WINDOW
    kblk = jnp.arange(nb)[:, None] + (jnp.arange(3 * BLOCK) // BLOCK)[None, :] - 1
    valid = (kblk >= 0) & (kblk < nb)
    mask = band[None] & valid[:, None, :]
    bias = rel_bias[t5_bucket(rel)].astype(jnp.float32)
    bias = bias.transpose(2, 0, 1).reshape(A_KV_HEADS, A_GROUP, BLOCK, 3 * BLOCK)
    s = jnp.einsum('bnqgrd,bnkgd->bngrqk', qb, kw).astype(jnp.float32) * (HEAD_DIM ** -0.5) + bias
    s = jnp.where(mask[None, :, None, None], s, NEG)
    sink_col = jnp.broadcast_to(sink.astype(jnp.float32).reshape(1, 1, A_KV_HEADS, A_GROUP, 1, 1), s.shape[:-1] + (1,))
    p = jax.nn.softmax(jnp.concatenate([s, sink_col], axis=-1), axis=-1)[..., :-1]
    o = jnp.einsum('bngrqk,bnkgd->bnqgrd', p.astype(v.dtype), vw)
    return o.reshape(B, S, A_HEADS * HEAD_DIM)


def mla_attend(q_nope, q_rope, k_nope, k_rope, v):
    B, S = q_nope.shape[0], q_nope.shape[1]
    nq = S // Q_BLOCK
    scale = (QK_NOPE + QK_ROPE) ** -0.5
    qn = jnp.moveaxis(q_nope.reshape(B, nq, Q_BLOCK, B_HEADS, QK_NOPE), 1, 0)
    qr = jnp.moveaxis(q_rope.reshape(B, nq, Q_BLOCK, B_HEADS, QK_ROPE), 1, 0)

    def block(args):
        qn_b, qr_b = args
        s = (jnp.einsum('bqhd,bkhd->bhqk', qn_b, k_nope) + jnp.einsum('bqhd,bkd->bhqk', qr_b, k_rope)).astype(jnp.float32) * scale
        p = jax.nn.softmax(s, axis=-1)
        return jnp.einsum('bhqk,bkhd->bqhd', p.astype(v.dtype), v)

    o = lax.map(block, (qn, qr))
    return jnp.moveaxis(o, 0, 1).reshape(B, S, B_HEADS * V_DIM)


def cross_attend(q, k, v):
    B, S = q.shape[0], q.shape[1]
    s = jnp.einsum('bqhd,bkhd->bhqk', q, k).astype(jnp.float32) * (HEAD_DIM ** -0.5)
    p = jax.nn.softmax(s, axis=-1)
    return jnp.einsum('bhqk,bkhd->bqhd', p.astype(v.dtype), v).reshape(B, S, C_HEADS * HEAD_DIM)


def encoder_layer(x, mem, w_in, rel_bias, sink, q_norm_g, w_uq, kv_norm_g, w_ukv, w_mem_kv,
                  w_gate, b_gate, w_br_a, w_br_b, w_br_c, w_o, ln1_g, ln1_b,
                  w_ffn_in, w_ffn_down, ln2_g, ln2_b):
    B, S, D = x.shape
    splits = [int(c) for c in np.cumsum(IN_WIDTHS)[:-1]]
    qa, ka, va, cq, ckv, kr, qc = jnp.split(x @ w_in, splits, axis=-1)

    a_out = window_gqa(qa.reshape(B, S, A_HEADS, HEAD_DIM), ka.reshape(B, S, A_KV_HEADS, HEAD_DIM),
                       va.reshape(B, S, A_KV_HEADS, HEAD_DIM), rel_bias, sink)

    cos, sin = rope_tables(S)
    qb = (rms_norm(cq, q_norm_g) @ w_uq).reshape(B, S, B_HEADS, QK_NOPE + QK_ROPE)
    q_nope = qb[..., :QK_NOPE]
    q_rope = apply_rope(qb[..., QK_NOPE:], cos[:, None, :], sin[:, None, :])
    kvb = (rms_norm(ckv, kv_norm_g) @ w_ukv).reshape(B, S, B_HEADS, QK_NOPE + V_DIM)
    k_nope, v_b = kvb[..., :QK_NOPE], kvb[..., QK_NOPE:]
    k_rope = apply_rope(kr, cos, sin)
    b_out = mla_attend(q_nope, q_rope, k_nope, k_rope, v_b)

    mkv = (mem @ w_mem_kv).reshape(B, N_MEM, 2, C_HEADS, HEAD_DIM)
    c_out = cross_attend(qc.reshape(B, S, C_HEADS, HEAD_DIM), mkv[:, :, 0], mkv[:, :, 1])

    g = jax.nn.sigmoid((x @ w_gate + b_gate).astype(jnp.float32)).astype(x.dtype).reshape(B, S, N_BRANCH, D)
    merged = g[:, :, 0] * (a_out @ w_br_a) + g[:, :, 1] * (b_out @ w_br_b) + g[:, :, 2] * (c_out @ w_br_c)
    h = layer_norm(ALPHA * x + merged @ w_o, ln1_g, ln1_b)

    gate, up = jnp.split(h @ w_ffn_in, 2, axis=-1)
    f = (jax.nn.silu(gate) * up) @ w_ffn_down
    return layer_norm(ALPHA * h + f, ln2_g, ln2_b)


def setup_inputs(seed: int = 0) -> dict:
    key = jax.random.key(seed)
    ks = iter(jax.random.split(key, 40))
    f32 = jnp.float32

    def nrm(shape, scale):
        return jax.random.normal(next(ks), shape, f32) * scale

    L, D = DEPTH, D_MODEL
    sd = D ** -0.5
    w_in_parts = []
    for i, w in enumerate(IN_WIDTHS):
        s = sd * BETA if i == 2 else sd
        w_in_parts.append(nrm((L, D, w), s))
    w_in = jnp.concatenate(w_in_parts, axis=-1)
    w_ukv = jnp.concatenate([nrm((L, KV_LORA, B_HEADS, 1, QK_NOPE), KV_LORA ** -0.5),
                             nrm((L, KV_LORA, B_HEADS, 1, V_DIM), KV_LORA ** -0.5 * BETA)], axis=3
                            ).reshape(L, KV_LORA, B_HEADS * (QK_NOPE + V_DIM))
    w_mem_kv = jnp.concatenate([nrm((L, D, C_HEADS * HEAD_DIM), sd),
                                nrm((L, D, C_HEADS * HEAD_DIM), sd * BETA)], axis=-1)
    return {
        "x_prompt": nrm((BATCH, SEQ, D), 1.0),
        "x_sample": nrm((DEC_BATCH, DEC_SEQ, D), 1.0),
        "mem_prompt": nrm((BATCH, N_MEM, D), 1.0),
        "mem_sample": nrm((DEC_BATCH, N_MEM, D), 1.0),
        "w_in": w_in,
        "rel_bias": nrm((N_BUCKETS, A_HEADS), 0.1),
        "sink": nrm((L, A_HEADS), 0.5),
        "q_norm_g": 1.0 + nrm((L, Q_LORA), 0.01),
        "w_uq": nrm((L, Q_LORA, B_HEADS * (QK_NOPE + QK_ROPE)), Q_LORA ** -0.5),
        "kv_norm_g": 1.0 + nrm((L, KV_LORA), 0.01),
        "w_ukv": w_ukv,
        "w_mem_kv": w_mem_kv,
        "w_gate": nrm((L, D, N_BRANCH * D), sd),
        "b_gate": nrm((L, N_BRANCH * D), 0.01),
        "w_br_a": nrm((L, A_HEADS * HEAD_DIM, D), (A_HEADS * HEAD_DIM) ** -0.5),
        "w_br_b": nrm((L, B_HEADS * V_DIM, D), (B_HEADS * V_DIM) ** -0.5),
        "w_br_c": nrm((L, C_HEADS * HEAD_DIM, D), (C_HEADS * HEAD_DIM) ** -0.5),
        "w_o": nrm((L, D, D), sd * BETA),
        "ln1_g": 1.0 + nrm((L, D), 0.01),
        "ln1_b": nrm((L, D), 0.01),
        "w_ffn_in": nrm((L, D, 2 * D_FF), sd * BETA),
        "w_ffn_down": nrm((L, D_FF, D), D_FF ** -0.5 * BETA),
        "ln2_g": 1.0 + nrm((L, D), 0.01),
        "ln2_b": nrm((L, D), 0.01),
    }


def reference(x_prompt, x_sample, mem_prompt, mem_sample, w_in, rel_bias, sink, q_norm_g, w_uq,
              kv_norm_g, w_ukv, w_mem_kv, w_gate, b_gate, w_br_a, w_br_b, w_br_c, w_o,
              ln1_g, ln1_b, w_ffn_in, w_ffn_down, ln2_g, ln2_b):
    def run(x, mem):
        for l in range(DEPTH):
            x = encoder_layer(x, mem, w_in[l], rel_bias, sink[l], q_norm_g[l], w_uq[l], kv_norm_g[l],
                              w_ukv[l], w_mem_kv[l], w_gate[l], b_gate[l], w_br_a[l], w_br_b[l],
                              w_br_c[l], w_o[l], ln1_g[l], ln1_b[l], w_ffn_in[l], w_ffn_down[l],
                              ln2_g[l], ln2_b[l])
        return x

    y_prompt = run(x_prompt, mem_prompt)
    y_sample = run(x_sample, mem_sample)
    return (y_prompt, y_sample)
```

```cpp
#include <hip/hip_runtime.h>
#include <hip/hip_cooperative_groups.h>
#include <cstdio>
#include <cstdint>
#include <cmath>
namespace cg = cooperative_groups;
#ifndef SGQ
#define SGQ 1
#endif
#ifndef SGP
#define SGP 1
#endif
#ifndef SGQ_PRE
#define SGQ_PRE 3
#endif
#ifndef SGP_PRE
#define SGP_PRE 4
#endif
#ifndef HOOKB
#define HOOKB 4
#endif
#ifndef REP_SYNC
#define REP_SYNC 0
#endif
#ifndef ATT_PRIO
#define ATT_PRIO 1
#endif
#ifndef P2R
#define P2R 4
#endif
#ifndef REP_ATT
#define REP_ATT 1
#endif
#ifndef REP_FFI
#define REP_FFI 1
#endif
#ifndef REP_G1
#define REP_G1 1
#endif

#define LAS __attribute__((address_space(3)))
typedef unsigned short bf16_t;
typedef short bf16x8 __attribute__((ext_vector_type(8)));
typedef short s16x4 __attribute__((ext_vector_type(4)));
typedef float f32x4 __attribute__((ext_vector_type(4)));
typedef float f32x2 __attribute__((ext_vector_type(2)));
typedef float f32x16 __attribute__((ext_vector_type(16)));
typedef unsigned u32x4 __attribute__((ext_vector_type(4)));
typedef unsigned u32x2 __attribute__((ext_vector_type(2)));
typedef int i32x8 __attribute__((ext_vector_type(8)));

constexpr int DM = 2048, T_TOK = 40960, T_PROMPT = 32768, SEQ_P = 16384, SEQ_S = 8192;
constexpr int NPROJ = 3072;
constexpr int C_QA = 0, C_KA = 768, C_VA = 1024, C_CQ = 1280, C_CKV = 1792, C_QC = 2304, C_KR = 2816;
constexpr int NGATE = 6144, NMKV = 1024, N1 = NPROJ + NGATE + NMKV;
constexpr int LDQB = 1280, LDKVB = 1536, NLAT = LDQB + LDKVB;
constexpr int DFF = 5632;
constexpr float ALPHA = 1.189207115002721f;
constexpr float LOG2E = 1.4426950408889634f;

constexpr size_t MiB = 1u << 20;
constexpr size_t WS_CTL = 0;
constexpr size_t WS_W1T = 1 * MiB, WS_WLAT = 41 * MiB, WS_WBA = 44 * MiB, WS_WBB = 47 * MiB, WS_WBC = 50 * MiB, WS_WO = 52 * MiB, WS_WFI = 60 * MiB, WS_WFD = 104 * MiB;
constexpr size_t WS_ROPE = 126 * MiB, WS_MKV = 130 * MiB, WS_RSTD = 132 * MiB, WS_KROPE = 133 * MiB;
constexpr size_t WS_R1 = 138 * MiB;
constexpr size_t WS_R2 = 302 * MiB;
constexpr size_t WS_R3 = 782 * MiB;
constexpr size_t WS_END = 1002 * MiB;
constexpr size_t R1_AOUT = 0, R1_BOUT = (size_t)T_TOK * 768 * 2, R1_COUT = (size_t)T_TOK * 1536 * 2;
constexpr size_t R3_QB = 0, R3_KVB = (size_t)T_TOK * LDQB * 2;

__device__ __forceinline__ unsigned cvt_pk_bf16(float lo, float hi) { unsigned r; asm volatile("v_cvt_pk_bf16_f32 %0, %1, %2" : "=v"(r) : "v"(lo), "v"(hi)); return r; }
__device__ __forceinline__ float bf_lo(unsigned u) { return __uint_as_float(u << 16); }
__device__ __forceinline__ float bf_hi(unsigned u) { return __uint_as_float(u & 0xffff0000u); }
__device__ __forceinline__ unsigned pk4_fp8(float a, float b, float c, float d) { int p = __builtin_amdgcn_cvt_pk_fp8_f32(a, b, 0, false); p = __builtin_amdgcn_cvt_pk_fp8_f32(c, d, p, true); return (unsigned)p; }
__device__ __forceinline__ float sigmoidf_(float v) { return __builtin_amdgcn_rcpf(1.0f + __builtin_amdgcn_exp2f(-v * LOG2E)); }

namespace pg8 {
constexpr int BM = 256, BK = 64, HALF = 128, HTB = HALF * BK * 2, STAGE_BYTES = 8 * HTB, NXCD = 8, WGM = 4;
__device__ __forceinline__ int lds_byte(int r, int c) { const int st = (r >> 4) * 2 + (c >> 5), rr = r & 15, cc = c & 31, ob = rr * 64 + cc * 2; return st * 1024 + (ob ^ (((ob >> 9) & 1) << 5)); }
__device__ __forceinline__ void stage_rc(int b, int& R, int& C) { const int st = b / 1024, sb = b % 1024, swz = sb ^ (((sb >> 9) & 1) << 5); R = (st >> 1) * 16 + swz / 64; C = (st & 1) * 32 + (swz % 64) / 2; }
__device__ __forceinline__ int perm32(int rho) { const int n = rho >> 4, i = rho & 15; return 8 * (i >> 2) + 4 * n + (i & 3); }

struct Unit { int pm, pn; long aoff, boff; int nt, seg; };
struct Gemm { const bf16_t* A; const bf16_t* Bt; int lda, K; };

__device__ __forceinline__ void static_unit(int nM, int nN, int L, Unit& u) {
    const int nwg = nM * nN; int wgid = L;
    { const int q = nwg / NXCD, r = nwg % NXCD, xcd = wgid % NXCD, off = wgid / NXCD; wgid = (xcd < r ? xcd * (q + 1) : r * (q + 1) + (xcd - r) * q) + off; }
    const int nig = WGM * nN, gid = wgid / nig, fm = gid * WGM, gsz = (nM - fm) < WGM ? (nM - fm) : WGM;
    u.pm = fm + ((wgid % nig) % gsz); u.pn = (wgid % nig) / gsz; u.aoff = 0; u.boff = 0; u.nt = 0; u.seg = 2;
}
struct StaticOrder {
    int nM, nN, nwg, G, c;
    __device__ void init(int M, int N, int G_, int c_) { nM = M / BM; nN = N / BM; nwg = nM * nN; G = G_; c = c_; }
    __device__ __forceinline__ bool next(int i, Unit& u) const { const long L = (long)i * G + c; if (L >= nwg) return false; static_unit(nM, nN, (int)L, u); return true; }
};
struct Order1 {
    int G, c;
    __device__ __forceinline__ bool next(int i, Unit& u) const { const long L = (long)i * G + c; constexpr int NMAIN = 160 * 12;
        if (L < NMAIN) { static_unit(160, 12, (int)L, u); return true; }
        if (L < NMAIN + 12) { const int r = (int)L - NMAIN; u.pm = 160 + r / 4; u.pn = 36 + r % 4; u.aoff = 0; u.boff = 0; u.nt = 0; u.seg = 2; return true; }
        return false; }
};
struct Order23 {
    int G, c;
    __device__ __forceinline__ bool next(int i, Unit& u) const { const long L = (long)i * G + c; if (L >= 160 * 11) return false; static_unit(160, 11, (int)L, u); u.aoff = (u.pn < 5) ? 0 : 512 * 2; return true; }
};

struct OrderMerge {
    int G, c;
    __device__ __forceinline__ bool next(int i, Unit& u) const { const int ti = i / 3, seg = i - 3 * ti; const long L = (long)ti * G + c; if (L >= 160 * 8) return false;
        static_unit(160, 8, (int)L, u); const int k0 = seg * 768; u.aoff = k0 * 2; u.boff = k0 * 2; u.nt = seg == 2 ? 8 : 12; u.seg = seg; return true; }
};
typedef long i64x2 __attribute__((ext_vector_type(2)));
template <class Epi, class Sched, bool F8 = false>
__device__ __forceinline__ void gemm_phase(LAS unsigned char* lds, const Gemm g, const Sched& S, const Epi& E) {
    int tid = threadIdx.x; asm volatile("" : "+v"(tid));
    const int wid = __builtin_amdgcn_readfirstlane(tid >> 6), lane = tid & 63, wr = wid >> 2, wc = wid & 3, fr = lane & 15, fq = lane >> 4;
    const int K = g.K, lda = g.lda;
    unsigned voffA[2], voffB[2];
#pragma unroll
    for (int i = 0; i < 2; ++i) { int R, C; stage_rc(tid * 16 + i * 8192, R, C); const int Rb = (R & ~31) + perm32(R & 31);
        voffA[i] = (unsigned)(R * lda + C) * 2u; voffB[i] = (unsigned)(Rb * K + C) * 2u; }
    const size_t kstep = (size_t)(BK * 2);
    const size_t hstepA = (size_t)HALF * lda * 2, hstepB = (size_t)HALF * K * 2;
    const size_t tstepA = 2 * hstepA, tstepB = 2 * hstepB;
    const unsigned ldsw = (unsigned)wid * 1024u;
    const int aoff = lds_byte(wr * 64 + fr, fq * 8), boff = lds_byte(wc * 32 + fr, fq * 8);
#define PG8_SA(b, h) (((b) * 2 + (h)) * HTB)
#define PG8_SB(b, h) ((4 + (b) * 2 + (h)) * HTB)
#define PG8_STAGE(bufoff, gbase, voff) do { _Pragma("unroll") for (int _i = 0; _i < 2; ++_i) \
        __builtin_amdgcn_global_load_lds((const unsigned*)((const char*)(gbase) + (voff)[_i]), (LAS unsigned*)(lds + (bufoff) + ldsw + _i * 8192), 16, 0, 0); } while (0)
#define PG8_LDA(dst, b, h) do { _Pragma("unroll") for (int m = 0; m < 4; ++m) _Pragma("unroll") for (int k = 0; k < 2; ++k) dst[m][k] = *(const LAS bf16x8*)(lds + PG8_SA(b, h) + aoff + m * 2048 + k * 1024); } while (0)
#define PG8_LDB(dst, b, h) do { _Pragma("unroll") for (int n = 0; n < 2; ++n) _Pragma("unroll") for (int k = 0; k < 2; ++k) dst[n][k] = *(const LAS bf16x8*)(lds + PG8_SB(b, h) + boff + n * 2048 + k * 1024); } while (0)
#define PG8_MMA(ai, bj, At, Bt) do { __builtin_amdgcn_s_setprio(1); _Pragma("unroll") for (int m = 0; m < 4; ++m) _Pragma("unroll") for (int n = 0; n < 2; ++n) _Pragma("unroll") for (int k = 0; k < 2; ++k) { \
        if constexpr (F8) { const i64x2 b_ = __builtin_bit_cast(i64x2, Bt[n][k]), a_ = __builtin_bit_cast(i64x2, At[m][k]); \
            acc[ai][bj][m][n] = __builtin_amdgcn_mfma_f32_16x16x32_fp8_fp8(b_[0], a_[0], acc[ai][bj][m][n], 0, 0, 0); acc[ai][bj][m][n] = __builtin_amdgcn_mfma_f32_16x16x32_fp8_fp8(b_[1], a_[1], acc[ai][bj][m][n], 0, 0, 0); } \
        else acc[ai][bj][m][n] = __builtin_amdgcn_mfma_f32_16x16x32_bf16(Bt[n][k], At[m][k], acc[ai][bj][m][n], 0, 0, 0); } \
        __builtin_amdgcn_s_setprio(0); } while (0)
#define PG8_WAIT_V(n) asm volatile("s_waitcnt vmcnt(" #n ")" ::: "memory")
#define PG8_WAIT_L(n) asm volatile("s_waitcnt lgkmcnt(" #n ")" ::: "memory")
#define PG8_BAR __builtin_amdgcn_s_barrier()
#define PG8_SCHED __builtin_amdgcn_sched_barrier(0)
    Unit cur, nxt; int ui = 0;
    if (!S.next(0, cur)) return;
    f32x4 acc[2][2][4][2];
#pragma unroll
    for (int a = 0; a < 2; ++a)
#pragma unroll
        for (int b = 0; b < 2; ++b)
#pragma unroll
            for (int m = 0; m < 4; ++m)
#pragma unroll
                for (int n = 0; n < 2; ++n) acc[a][b][m][n] = (f32x4){0.f, 0.f, 0.f, 0.f};
    bf16x8 At[4][2], B0[2][2], B1[2][2];
    const char* cA = (const char*)g.A + (size_t)cur.pm * tstepA + cur.aoff; const char* cB = (const char*)g.Bt + (size_t)cur.pn * tstepB + cur.boff;
    PG8_STAGE(PG8_SB(0, 0), cB, voffB); PG8_STAGE(PG8_SB(0, 1), cB + hstepB, voffB); PG8_STAGE(PG8_SA(0, 0), cA, voffA); PG8_STAGE(PG8_SA(0, 1), cA + hstepA, voffA);
    if (wr == 1) PG8_BAR;
    PG8_WAIT_V(2); PG8_BAR;
    PG8_STAGE(PG8_SB(1, 0), cB + kstep, voffB); PG8_STAGE(PG8_SA(1, 0), cA + kstep, voffA); PG8_STAGE(PG8_SB(1, 1), cB + hstepB + kstep, voffB);
    PG8_WAIT_V(6); PG8_BAR;
    for (;;) {
        const bool has_next = S.next(ui + 1, nxt);
        const char* nA = has_next ? (const char*)g.A + (size_t)nxt.pm * tstepA + nxt.aoff : cA; const char* nB = has_next ? (const char*)g.Bt + (size_t)nxt.pn * tstepB + nxt.boff : cB;
        const int nt = cur.nt ? cur.nt : K / BK;
        for (int t = 0; t < nt; t += 2) {
            const bool last = (t == nt - 2);
            const char* a1 = cA + (size_t)(t + 1) * kstep;
            const char* a2 = last ? nA : cA + (size_t)(t + 2) * kstep; const char* b2 = last ? nB : cB + (size_t)(t + 2) * kstep;
            const char* a3 = a2 + kstep; const char* b3 = b2 + kstep;
            PG8_LDB(B0, 0, 0); PG8_LDB(B1, 0, 1); PG8_SCHED; PG8_LDA(At, 0, 0); PG8_STAGE(PG8_SA(1, 1), a1 + hstepA, voffA);
            PG8_WAIT_V(8); PG8_WAIT_L(0); PG8_BAR; PG8_MMA(0, 0, At, B0); PG8_MMA(0, 1, At, B1); PG8_BAR; PG8_SCHED;
            PG8_LDA(At, 0, 1); PG8_STAGE(PG8_SB(0, 0), b2, voffB); PG8_STAGE(PG8_SB(0, 1), b2 + hstepB, voffB); PG8_STAGE(PG8_SA(0, 0), a2, voffA);
            PG8_WAIT_V(8); PG8_WAIT_L(0); PG8_BAR; PG8_MMA(1, 0, At, B0); PG8_MMA(1, 1, At, B1); PG8_BAR; PG8_SCHED;
            PG8_LDB(B0, 1, 0); PG8_LDB(B1, 1, 1); PG8_SCHED; PG8_LDA(At, 1, 0); PG8_STAGE(PG8_SA(0, 1), a2 + hstepA, voffA);
            PG8_WAIT_V(8); PG8_WAIT_L(0); PG8_BAR; PG8_MMA(0, 0, At, B0); PG8_MMA(0, 1, At, B1); PG8_BAR; PG8_SCHED;
            PG8_LDA(At, 1, 1); PG8_STAGE(PG8_SB(1, 0), b3, voffB); PG8_STAGE(PG8_SB(1, 1), b3 + hstepB, voffB); PG8_STAGE(PG8_SA(1, 0), a3, voffA);
            PG8_WAIT_V(8); PG8_WAIT_L(0); PG8_BAR; PG8_MMA(1, 0, At, B0); PG8_MMA(1, 1, At, B1); PG8_BAR; PG8_SCHED;
        }
        if (wr == 0) PG8_BAR;
        E(acc, cur, wr, wc, fr, fq);
        if (!has_next) break;
        if (!(Epi::HAS_HOOK && cur.seg != 2)) {
#pragma unroll
        for (int a = 0; a < 2; ++a)
#pragma unroll
            for (int b = 0; b < 2; ++b)
#pragma unroll
                for (int m = 0; m < 4; ++m)
#pragma unroll
                    for (int n = 0; n < 2; ++n) acc[a][b][m][n] = (f32x4){0.f, 0.f, 0.f, 0.f};
        }
        cur = nxt; cA = nA; cB = nB; ++ui;
        if (wr == 1) PG8_BAR;
    }
    PG8_WAIT_V(0);
    PG8_BAR;
#undef PG8_SA
#undef PG8_SB
#undef PG8_STAGE
#undef PG8_LDA
#undef PG8_LDB
#undef PG8_MMA
#undef PG8_WAIT_V
#undef PG8_WAIT_L
#undef PG8_BAR
#undef PG8_SCHED
}

typedef f32x4 Acc[2][2][4][2];
#define EPI_LOOP_ROWS  _Pragma("unroll") for (int ai = 0; ai < 2; ++ai) _Pragma("unroll") for (int m = 0; m < 4; ++m)
__device__ __forceinline__ u32x4 pack8(f32x4 v0, f32x4 v1) { u32x4 w; w.x = cvt_pk_bf16(v0[0], v0[1]); w.y = cvt_pk_bf16(v0[2], v0[3]); w.z = cvt_pk_bf16(v1[0], v1[1]); w.w = cvt_pk_bf16(v1[2], v1[3]); return w; }

struct EpiProj {
    static constexpr bool HAS_HOOK = false;
    bf16_t* proj; bf16_t* gates; bf16_t* mkv; const float* bgate;
    __device__ __forceinline__ void operator()(const Acc& acc, const Unit& u, int wr, int wc, int fr, int fq) const {
        bf16_t* base; int ld, colt, rowt; bool act = false;
        if (u.pn < 12) { base = proj; ld = NPROJ; colt = u.pn * 256; rowt = u.pm * 256; }
        else if (u.pn < 36) { base = gates; ld = NGATE; colt = (u.pn - 12) * 256; rowt = u.pm * 256; act = true; }
        else { base = mkv; ld = NMKV; colt = (u.pn - 36) * 256; rowt = (u.pm - 160) * 256; }
        const int col0 = colt + wc * 32 + 8 * fq;
        f32x4 bv[2][2];
#pragma unroll
        for (int bj = 0; bj < 2; ++bj)
#pragma unroll
            for (int n = 0; n < 2; ++n) bv[bj][n] = act ? *(const f32x4*)(bgate + col0 + bj * HALF + 4 * n) : (f32x4){0.f, 0.f, 0.f, 0.f};
        EPI_LOOP_ROWS { bf16_t* rowp = base + (size_t)(rowt + ai * HALF + wr * 64 + m * 16 + fr) * ld + col0;
#pragma unroll
            for (int bj = 0; bj < 2; ++bj) { f32x4 v0 = acc[ai][bj][m][0] + bv[bj][0], v1 = acc[ai][bj][m][1] + bv[bj][1];
                if (act) {
#pragma unroll
                    for (int e = 0; e < 4; ++e) { v0[e] = sigmoidf_(v0[e]); v1[e] = sigmoidf_(v1[e]); } }
                *(u32x4*)(rowp + bj * HALF) = pack8(v0, v1); } }
    }
};
struct EpiGate {
    static constexpr bool HAS_HOOK = false;
    bf16_t* gates; const float* bgate;
    __device__ __forceinline__ void operator()(const Acc& acc, const Unit& u, int wr, int wc, int fr, int fq) const {
        const int col0 = u.pn * 256 + wc * 32 + 8 * fq;
        EPI_LOOP_ROWS { bf16_t* rowp = gates + (size_t)(u.pm * 256 + ai * HALF + wr * 64 + m * 16 + fr) * NGATE + col0;
#pragma unroll
            for (int bj = 0; bj < 2; ++bj) { f32x4 v0 = acc[ai][bj][m][0] * 0.015625f + *(const f32x4*)(bgate + col0 + bj * HALF), v1 = acc[ai][bj][m][1] * 0.015625f + *(const f32x4*)(bgate + col0 + bj * HALF + 4);
#pragma unroll
                for (int e = 0; e < 4; ++e) { v0[e] = sigmoidf_(v0[e]); v1[e] = sigmoidf_(v1[e]); }
                *(u32x4*)(rowp + bj * HALF) = pack8(v0, v1); } }
    }
};
struct EpiLat {
    static constexpr bool HAS_HOOK = false;
    bf16_t* qb; bf16_t* kvb; const float* rstd;
    LAS unsigned char* ldsx; unsigned char* vt;
    __device__ __forceinline__ void operator()(const Acc& acc, const Unit& u, int wr, int wc, int fr, int fq) const {
        bf16_t* base; int ld, colt, which;
        if (u.pn < 5) { base = qb; ld = LDQB; colt = u.pn * 256; which = 0; } else { base = kvb; ld = LDKVB; colt = (u.pn - 5) * 256; which = 1; }
        const int col0 = colt + wc * 32 + 8 * fq;
        EPI_LOOP_ROWS { const int row = u.pm * 256 + ai * HALF + wr * 64 + m * 16 + fr; const float s = rstd[row * 2 + which]; bf16_t* rowp = base + (size_t)row * ld + col0;
            if (which == 0) {
#pragma unroll
                for (int bj = 0; bj < 2; ++bj) *(u32x4*)(rowp + bj * HALF) = pack8(acc[ai][bj][m][0] * s, acc[ai][bj][m][1] * s);
            } else {
                const f32x4 k0 = acc[ai][0][m][0] * s, k1 = acc[ai][0][m][1] * s;
                u32x2 w; w.x = pk4_fp8(k0[0], k0[1], k0[2], k0[3]); w.y = pk4_fp8(k1[0], k1[1], k1[2], k1[3]);
                *(u32x2*)((char*)kvb + (size_t)row * (LDKVB * 2) + (size_t)(u.pn - 5) * 512 + wc * 32 + 8 * fq) = w;
                const f32x4 v0 = acc[ai][1][m][0] * s, v1 = acc[ai][1][m][1] * s; const unsigned q0 = pk4_fp8(v0[0], v0[1], v0[2], v0[3]), q1 = pk4_fp8(v1[0], v1[1], v1[2], v1[3]);
                LAS unsigned char* sp = ldsx + 131072 + (wr * 4 + wc) * 2048 + (8 * fq) * 64 + 16 * m + fr;
                sp[0 * 64] = (unsigned char)(q0); sp[1 * 64] = (unsigned char)(q0 >> 8); sp[2 * 64] = (unsigned char)(q0 >> 16); sp[3 * 64] = (unsigned char)(q0 >> 24);
                sp[4 * 64] = (unsigned char)(q1); sp[5 * 64] = (unsigned char)(q1 >> 8); sp[6 * 64] = (unsigned char)(q1 >> 16); sp[7 * 64] = (unsigned char)(q1 >> 24);
                if (m == 3) {
                    asm volatile("s_waitcnt lgkmcnt(0)" ::: "memory");
                    const int pm = u.pm, sq = pm < 64 ? 0 : (pm < 128 ? 1 : 2), slen = sq < 2 ? SEQ_P : SEQ_S, pos0 = pm * 256 - (sq < 2 ? sq * SEQ_P : T_PROMPT);
                    unsigned char* vth = vt + (size_t)sq * (6 * 128 * SEQ_P) + (size_t)(u.pn - 5) * 128 * slen;
                    const int lane_ = fq * 16 + fr; LAS unsigned char* wb = ldsx + 131072 + (wr * 4 + wc) * 2048;
#pragma unroll
                    for (int c2 = 0; c2 < 2; ++c2) { const int id = lane_ + 64 * c2, col = id >> 2, seg = id & 3;
                        const u32x4 vv = *(const LAS u32x4*)(wb + col * 64 + seg * 16);
                        *(u32x4*)(vth + (size_t)(32 * wc + col) * slen + pos0 + ai * HALF + wr * 64 + seg * 16) = vv; }
                    asm volatile("s_waitcnt lgkmcnt(0)" ::: "memory");
                }
            } }
    }
};
struct EpiMerge {
    static constexpr bool HAS_HOOK = false;
    bf16_t* X; const bf16_t* gates; int br;
    __device__ __forceinline__ void operator()(const Acc& acc, const Unit& u, int wr, int wc, int fr, int fq) const {
        const int col0 = u.pn * 256 + wc * 32 + 8 * fq;
        EPI_LOOP_ROWS { const int row = u.pm * 256 + ai * HALF + wr * 64 + m * 16 + fr;
#pragma unroll
            for (int bj = 0; bj < 2; ++bj) { const int col = col0 + bj * HALF;
                const u32x4 gv = *(const u32x4*)(gates + (size_t)row * NGATE + br * DM + col);
                f32x4 p0 = (f32x4){0.f, 0.f, 0.f, 0.f}, p1 = p0;
                if (br) { const u32x4 pv = *(const u32x4*)(X + (size_t)row * DM + col); p0 = (f32x4){bf_lo(pv.x), bf_hi(pv.x), bf_lo(pv.y), bf_hi(pv.y)}; p1 = (f32x4){bf_lo(pv.z), bf_hi(pv.z), bf_lo(pv.w), bf_hi(pv.w)}; }
                const f32x4 g0 = (f32x4){bf_lo(gv.x), bf_hi(gv.x), bf_lo(gv.y), bf_hi(gv.y)}, g1 = (f32x4){bf_lo(gv.z), bf_hi(gv.z), bf_lo(gv.w), bf_hi(gv.w)};
                *(u32x4*)(X + (size_t)row * DM + col) = pack8(p0 + g0 * acc[ai][bj][m][0], p1 + g1 * acc[ai][bj][m][1]); } }
    }
};
struct EpiMergeF {
    static constexpr bool HAS_HOOK = true;
    bf16_t* X; const bf16_t* gates;
    __device__ __forceinline__ void operator()(Acc& acc, const Unit& u, int wr, int wc, int fr, int fq) const {
        const int seg = u.seg; const bool fin = seg == 2;
        unsigned off = (unsigned)(((u.pm * 256 + wr * 64 + fr) * NGATE + u.pn * 256 + wc * 32 + 8 * fq + seg * DM) * 2);
        const unsigned doff = fin ? 0u : (unsigned)(DM * 2);
        asm volatile("" : "+v"(off));
        const char* gb = (const char*)gates;
#pragma unroll
        for (int ai = 0; ai < 2; ++ai)
#pragma unroll
            for (int mp = 0; mp < 4; mp += HOOKB) {
                u32x4 gn[HOOKB][2], gd[HOOKB][2];
#pragma unroll
                for (int mm = 0; mm < HOOKB; ++mm)
#pragma unroll
                    for (int bj = 0; bj < 2; ++bj) { const unsigned o = off + (unsigned)(((ai * HALF + (mp + mm) * 16) * NGATE + bj * HALF) * 2);
                        gn[mm][bj] = *(const u32x4*)(gb + o); gd[mm][bj] = *(const u32x4*)(gb + o + doff); }
#pragma unroll
                for (int mm = 0; mm < HOOKB; ++mm)
#pragma unroll
                    for (int bj = 0; bj < 2; ++bj) {
#pragma unroll
                        for (int e = 0; e < 4; ++e) { const float n0 = bf_lo(gn[mm][bj][e]), n1 = bf_hi(gn[mm][bj][e]), d0 = bf_lo(gd[mm][bj][e]), d1 = bf_hi(gd[mm][bj][e]);
                            const float r0 = fin ? n0 : n0 * __builtin_amdgcn_rcpf(fmaxf(d0, 1e-20f)), r1 = fin ? n1 : n1 * __builtin_amdgcn_rcpf(fmaxf(d1, 1e-20f));
                            acc[ai][bj][mp + mm][e >> 1][(e & 1) * 2] *= r0; acc[ai][bj][mp + mm][e >> 1][(e & 1) * 2 + 1] *= r1; } }
                asm volatile("" ::: "memory");
            }
        if (fin) {
            unsigned xoff = (unsigned)(((u.pm * 256 + wr * 64 + fr) * DM + u.pn * 256 + wc * 32 + 8 * fq) * 2);
            asm volatile("" : "+v"(xoff));
            char* xb = (char*)X;
            EPI_LOOP_ROWS {
#pragma unroll
                for (int bj = 0; bj < 2; ++bj) *(u32x4*)(xb + xoff + (unsigned)(((ai * HALF + m * 16) * DM + bj * HALF) * 2)) = pack8(acc[ai][bj][m][0], acc[ai][bj][m][1]); }
        }
    }
};
struct EpiResLN {
    static constexpr bool HAS_HOOK = false;
    float* out; const f32x2* stats; const float* lg; const float* lb;
    __device__ __forceinline__ void operator()(const Acc& acc, const Unit& u, int wr, int wc, int fr, int fq) const {
        const int col0 = u.pn * 256 + wc * 32 + 8 * fq;
        f32x4 gg[2][2], bb[2][2];
#pragma unroll
        for (int bj = 0; bj < 2; ++bj)
#pragma unroll
            for (int n = 0; n < 2; ++n) { gg[bj][n] = *(const f32x4*)(lg + col0 + bj * HALF + 4 * n) * ALPHA; bb[bj][n] = *(const f32x4*)(lb + col0 + bj * HALF + 4 * n) * ALPHA; }
        EPI_LOOP_ROWS { const int row = u.pm * 256 + ai * HALF + wr * 64 + m * 16 + fr; const f32x2 st = stats[row]; float* rp = out + (size_t)row * DM + col0;
#pragma unroll
            for (int bj = 0; bj < 2; ++bj) { const f32x4 r0 = *(const f32x4*)(rp + bj * HALF), r1 = *(const f32x4*)(rp + bj * HALF + 4);
                *(f32x4*)(rp + bj * HALF) = ((r0 - st.x) * st.y) * gg[bj][0] + bb[bj][0] + acc[ai][bj][m][0];
                *(f32x4*)(rp + bj * HALF + 4) = ((r1 - st.x) * st.y) * gg[bj][1] + bb[bj][1] + acc[ai][bj][m][1]; } }
    }
};
struct EpiRes {
    static constexpr bool HAS_HOOK = false;
    const float* resA; const float* resB; float* out;
    __device__ __forceinline__ void operator()(const Acc& acc, const Unit& u, int wr, int wc, int fr, int fq) const {
        const int col0 = u.pn * 256 + wc * 32 + 8 * fq;
        const float* rb = (u.pm < 128) ? resA + (size_t)u.pm * 256 * DM : resB + (size_t)(u.pm - 128) * 256 * DM;
        float* ob = out + (size_t)u.pm * 256 * DM;
        EPI_LOOP_ROWS { const size_t off = (size_t)(ai * HALF + wr * 64 + m * 16 + fr) * DM + col0;
#pragma unroll
            for (int bj = 0; bj < 2; ++bj) { const f32x4 r0 = *(const f32x4*)(rb + off + bj * HALF), r1 = *(const f32x4*)(rb + off + bj * HALF + 4);
                *(f32x4*)(ob + off + bj * HALF) = r0 * ALPHA + acc[ai][bj][m][0]; *(f32x4*)(ob + off + bj * HALF + 4) = r1 * ALPHA + acc[ai][bj][m][1]; } }
    }
};
struct EpiSwiglu {
    static constexpr bool HAS_HOOK = false;
    bf16_t* act;
    __device__ __forceinline__ void operator()(const Acc& acc, const Unit& u, int wr, int wc, int fr, int fq) const {
        const int col0 = u.pn * 128 + wc * 32 + 8 * fq;
        EPI_LOOP_ROWS { const int row = u.pm * 256 + ai * HALF + wr * 64 + m * 16 + fr;
            f32x4 g0 = acc[ai][0][m][0], g1 = acc[ai][0][m][1]; const f32x4 u0 = acc[ai][1][m][0], u1 = acc[ai][1][m][1];
#pragma unroll
            for (int e = 0; e < 4; ++e) { g0[e] = g0[e] * sigmoidf_(g0[e]) * u0[e]; g1[e] = g1[e] * sigmoidf_(g1[e]) * u1[e]; }
            *(u32x4*)(act + (size_t)row * DFF + col0) = pack8(g0, g1); }
    }
};
}

namespace att {
constexpr int NW = 8, QBLK = 32, KVBLK = 64;
constexpr int SHM_V = 16384, SHM_K = 16384, SHM_KR = 8192;
constexpr int OFF_V = 0, OFF_K = 32768, OFF_KR = 65536, OFF_WS = 81920, OFF_QR = 83968, OFF_BT = 116736, OFF_IDX = 117888, LDS_END = 117904;
#define KSWZ(row, colB) ((row) * 256 + ((colB) ^ (((row) & 7) << 4)))
#define KRSWZ(row, colB) ((row) * 128 + ((colB) ^ (((row) & 7) << 4)))
#define SBAR() __builtin_amdgcn_sched_barrier(0)
__device__ __forceinline__ int crow(int r, int hi) { return (r & 3) + 8 * (r >> 2) + 4 * hi; }
typedef __bf16 bf16x2_t __attribute__((ext_vector_type(2)));
__device__ __forceinline__ unsigned cvtpk(float lo, float hi) { f32x2 v = {lo, hi}; bf16x2_t b = __builtin_convertvector(v, bf16x2_t); return __builtin_bit_cast(unsigned, b); }
__device__ __forceinline__ bf16x8 ld8(const bf16_t* p) { return *reinterpret_cast<const bf16x8*>(p); }

template <int MODE>
__device__ __forceinline__ void partialSM(f32x16& p0, f32x16& p1, float& m_reg, float& mn, float& alpha, const float C, int kb, const float* btab, const bool nomask) {
  if constexpr (MODE == 1) {
#pragma unroll
    for (int r = 0; r < 16; ++r) { const int i0 = kb + (r & 3) + 8 * (r >> 2), i1 = i0 + 32;
      const bool v0 = nomask || (unsigned)i0 <= 256u, v1 = nomask || (unsigned)i1 <= 256u;
      const float b0 = btab[nomask ? 257 : (v0 ? i0 : 0)], b1 = btab[nomask ? 257 : (v1 ? i1 : 0)];
      p0[r] = v0 ? fmaf(p0[r], C, b0) : -1e30f; p1[r] = v1 ? fmaf(p1[r], C, b1) : -1e30f; }
    float pmax = p0[0];
#pragma unroll
    for (int r = 1; r < 16; ++r) pmax = fmaxf(pmax, p0[r]);
#pragma unroll
    for (int r = 0; r < 16; ++r) pmax = fmaxf(pmax, p1[r]);
    { auto rr = __builtin_amdgcn_permlane32_swap(__float_as_uint(pmax), __float_as_uint(pmax), false, false); pmax = fmaxf(__uint_as_float(rr[0]), __uint_as_float(rr[1])); }
    { const bool keep = __all(pmax - m_reg <= 11.5f); mn = keep ? m_reg : fmaxf(m_reg, pmax); alpha = __builtin_amdgcn_exp2f(m_reg - mn); m_reg = mn; }
#pragma unroll
    for (int r = 0; r < 16; ++r) { p0[r] -= mn; p1[r] -= mn; }
#pragma unroll
    for (int r = 0; r < 16; ++r) p0[r] = __builtin_amdgcn_exp2f(p0[r]);
  } else {
    float pmax = p0[0];
#pragma unroll
    for (int r = 1; r < 16; ++r) pmax = fmaxf(pmax, p0[r]);
#pragma unroll
    for (int r = 0; r < 16; ++r) pmax = fmaxf(pmax, p1[r]);
    { auto rr = __builtin_amdgcn_permlane32_swap(__float_as_uint(pmax), __float_as_uint(pmax), false, false); pmax = fmaxf(__uint_as_float(rr[0]), __uint_as_float(rr[1])); }
    { const bool keep = __all((pmax - m_reg) * C <= (MODE == 0 ? 7.5f : 11.5f)); mn = keep ? m_reg : fmaxf(m_reg, pmax);   alpha = __builtin_amdgcn_exp2f((m_reg - mn) * C); m_reg = mn; }
    const float mnC = -mn * C;
#pragma unroll
    for (int r = 0; r < 16; ++r) p0[r] = fmaf(p0[r], C, mnC);
#pragma unroll
    for (int r = 0; r < 16; ++r) p1[r] = fmaf(p1[r], C, mnC);
#pragma unroll
    for (int r = 0; r < 16; ++r) p0[r] = __builtin_amdgcn_exp2f(p0[r]);
  }
}
__device__ __forceinline__ void finishSM(f32x16& p0, f32x16& p1, float alpha, float& l_reg, bf16x8& pa0, bf16x8& pa1, bf16x8& pa2, bf16x8& pa3) {
#pragma unroll
  for (int r = 0; r < 16; ++r) p1[r] = __builtin_amdgcn_exp2f(p1[r]);
  float ps = 0;
#pragma unroll
  for (int r = 0; r < 16; ++r) ps += p0[r];
#pragma unroll
  for (int r = 0; r < 16; ++r) ps += p1[r];
  { auto rr = __builtin_amdgcn_permlane32_swap(__float_as_uint(ps), __float_as_uint(ps), false, false); ps = __uint_as_float(rr[0]) + __uint_as_float(rr[1]); }
  l_reg = l_reg * alpha + ps;
#define PK4(P, BASE, OUT) do { unsigned a0 = cvtpk(P[BASE + 0], P[BASE + 1]), a1 = cvtpk(P[BASE + 2], P[BASE + 3]);   \
    unsigned b0 = cvtpk(P[BASE + 4], P[BASE + 5]), b1 = cvtpk(P[BASE + 6], P[BASE + 7]);                              \
    auto r0 = __builtin_amdgcn_permlane32_swap(a0, b0, false, false); auto r1 = __builtin_amdgcn_permlane32_swap(a1, b1, false, false); \
    u32x4 w = {r0[0], r1[0], r0[1], r1[1]}; OUT = *reinterpret_cast<bf16x8*>(&w); } while (0)
  PK4(p0, 0, pa0); PK4(p0, 8, pa1); PK4(p1, 0, pa2); PK4(p1, 8, pa3);
#undef PK4
}
template <int MODE>
__device__ __forceinline__ void qkt(f32x16& p0, f32x16& p1, const char* Ks, const char* Krs, const char* Qrs, const bf16x8* qr, const i32x8* q8, int r32, int hi) {
  p0 = f32x16{}; p1 = f32x16{};
  if constexpr (MODE == 0) {
#pragma unroll
    for (int kb = 0; kb < 3; ++kb) {
#pragma unroll
      for (int hf = 0; hf < 2; ++hf) { const char* a_ = Ks + (hf * 32 + r32) * 208 + kb * 64 + hi * 32;
        const u32x4 lo = *reinterpret_cast<const u32x4*>(a_), h4 = *reinterpret_cast<const u32x4*>(a_ + 16);
        const i32x8 a = {(int)lo.x, (int)lo.y, (int)lo.z, (int)lo.w, (int)h4.x, (int)h4.y, (int)h4.z, (int)h4.w};
        if (hf) p1 = __builtin_amdgcn_mfma_scale_f32_32x32x64_f8f6f4(a, q8[kb], p1, 0, 0, 0, 0x7F7F7F7F, 0, 0x7F7F7F7F);
        else p0 = __builtin_amdgcn_mfma_scale_f32_32x32x64_f8f6f4(a, q8[kb], p0, 0, 0, 0, 0x7F7F7F7F, 0, 0x7F7F7F7F); } }
  } else {
#pragma unroll
    for (int d0 = 0; d0 < 8; ++d0) { const int cb = (d0 * 16 + hi * 8) * 2;
      const bf16x8 b0 = *reinterpret_cast<const bf16x8*>(Ks + KSWZ(r32, cb));
      const bf16x8 b1 = *reinterpret_cast<const bf16x8*>(Ks + KSWZ(32 + r32, cb));
      p0 = __builtin_amdgcn_mfma_f32_32x32x16_bf16(b0, qr[d0], p0, 0, 0, 0);
      p1 = __builtin_amdgcn_mfma_f32_32x32x16_bf16(b1, qr[d0], p1, 0, 0, 0); }
  }
}
__device__ __forceinline__ int v_st(int k, int c) { const int kk = (k & ~0xC) | ((k & 4) << 1) | ((k & 8) >> 1); return ((kk >> 3) * 4 + (c >> 5)) * 512 + ((kk & 7) * 32 + (c & 31)) * 2; }
__device__ __forceinline__ int v_rd_base(int lane) { return ((lane & 3) << 3) | (((lane >> 2) & 3) << 6) | (((lane >> 4) & 1) << 5) | (((lane >> 5) & 1) << 8); }
constexpr int v_rd_off(int d0, int ks, int half) { return d0 * 512 + ks * 4096 + half * 2048; }
typedef short v4i16_t __attribute__((ext_vector_type(4)));
template <int OFF> __device__ __forceinline__ s16x4 tr_read(int vb) {
  return __builtin_bit_cast(s16x4, __builtin_amdgcn_ds_read_tr16_b64_v4i16((__attribute__((address_space(3))) v4i16_t*)(uintptr_t)(unsigned)(vb + OFF)));
}
template <int D0> __device__ __forceinline__ void pv_one(f32x16& od, int vb, bf16x8 pa0, bf16x8 pa1, bf16x8 pa2, bf16x8 pa3) {
  const s16x4 l0 = tr_read<v_rd_off(D0, 0, 0)>(vb), h0 = tr_read<v_rd_off(D0, 0, 1)>(vb), l1 = tr_read<v_rd_off(D0, 1, 0)>(vb), h1 = tr_read<v_rd_off(D0, 1, 1)>(vb);
  const s16x4 l2 = tr_read<v_rd_off(D0, 2, 0)>(vb), h2 = tr_read<v_rd_off(D0, 2, 1)>(vb), l3 = tr_read<v_rd_off(D0, 3, 0)>(vb), h3 = tr_read<v_rd_off(D0, 3, 1)>(vb);
#define PK(L, H) (bf16x8){L[0], L[1], L[2], L[3], H[0], H[1], H[2], H[3]}
  od = __builtin_amdgcn_mfma_f32_32x32x16_bf16(pa0, PK(l0, h0), od, 0, 0, 0);
  od = __builtin_amdgcn_mfma_f32_32x32x16_bf16(pa1, PK(l1, h1), od, 0, 0, 0);
  od = __builtin_amdgcn_mfma_f32_32x32x16_bf16(pa2, PK(l2, h2), od, 0, 0, 0);
  od = __builtin_amdgcn_mfma_f32_32x32x16_bf16(pa3, PK(l3, h3), od, 0, 0, 0);
#undef PK
}
__device__ __forceinline__ void pv_d0(f32x16* o, int vb, bf16x8 pa0, bf16x8 pa1, bf16x8 pa2, bf16x8 pa3) {
  pv_one<0>(o[0], vb, pa0, pa1, pa2, pa3); pv_one<1>(o[1], vb, pa0, pa1, pa2, pa3); pv_one<2>(o[2], vb, pa0, pa1, pa2, pa3); pv_one<3>(o[3], vb, pa0, pa1, pa2, pa3);
}

__device__ __forceinline__ void finishSM8(f32x16& p0, f32x16& p1, float alpha, float& l_reg, bf16x8& pa0, bf16x8& pa1) {
#pragma unroll
  for (int r = 0; r < 16; ++r) p1[r] = __builtin_amdgcn_exp2f(p1[r]);
  float ps = 0;
#pragma unroll
  for (int r = 0; r < 16; ++r) ps += p0[r];
#pragma unroll
  for (int r = 0; r < 16; ++r) ps += p1[r];
  { auto rr = __builtin_amdgcn_permlane32_swap(__float_as_uint(ps), __float_as_uint(ps), false, false); ps = __uint_as_float(rr[0]) + __uint_as_float(rr[1]); }
  l_reg = l_reg * alpha + ps;
  const u32x4 w0 = {pk4_fp8(p0[0], p0[1], p0[2], p0[3]), pk4_fp8(p0[4], p0[5], p0[6], p0[7]), pk4_fp8(p0[8], p0[9], p0[10], p0[11]), pk4_fp8(p0[12], p0[13], p0[14], p0[15])};
  const u32x4 w1 = {pk4_fp8(p1[0], p1[1], p1[2], p1[3]), pk4_fp8(p1[4], p1[5], p1[6], p1[7]), pk4_fp8(p1[8], p1[9], p1[10], p1[11]), pk4_fp8(p1[12], p1[13], p1[14], p1[15])};
  pa0 = __builtin_bit_cast(bf16x8, w0); pa1 = __builtin_bit_cast(bf16x8, w1);
}
__device__ __forceinline__ void pv8(f32x16* o, const char* Vs, bf16x8 pa0, bf16x8 pa1, int r32, int hi) {
  const u32x4 a0 = __builtin_bit_cast(u32x4, pa0), a1 = __builtin_bit_cast(u32x4, pa1);
  const i32x8 P = {(int)a0.x, (int)a0.y, (int)a0.z, (int)a0.w, (int)a1.x, (int)a1.y, (int)a1.z, (int)a1.w};
#pragma unroll
  for (int d0 = 0; d0 < 4; ++d0) { const char* b_ = Vs + (d0 * 32 + r32) * 80 + hi * 32;
    const u32x4 lo = *reinterpret_cast<const u32x4*>(b_), h4 = *reinterpret_cast<const u32x4*>(b_ + 16);
    const i32x8 V = {(int)lo.x, (int)lo.y, (int)lo.z, (int)lo.w, (int)h4.x, (int)h4.y, (int)h4.z, (int)h4.w};
    o[d0] = __builtin_amdgcn_mfma_scale_f32_32x32x64_f8f6f4(P, V, o[d0], 0, 0, 0, 0x7F7F7F7F, 0, 0x7F7F7F7F); }
}

template <int MODE, int SD>
__device__ __forceinline__ void attn_body(const bf16_t* __restrict__ Qb, const bf16_t* __restrict__ Kh, const bf16_t* __restrict__ Vh, const bf16_t* __restrict__ Krp,
                                          bf16_t* __restrict__ Ob, int NT, const float C, const f32x2* __restrict__ cs, int kbw, float sink_l2, const bool nomask,
                                          const int LDQ, const int LDK, const int LDO, char* lds) {
  int tid = threadIdx.x; asm volatile("" : "+v"(tid));
  const int wid = tid >> 6, lane = tid & 63, r32 = lane & 31, hi = lane >> 5;
  if (ATT_PRIO && wid >= 4) __builtin_amdgcn_s_setprio(1);
  char* V_lds = lds + OFF_V; char* K_lds = lds + OFF_K; char* Kr_lds = lds + OFF_KR;
  float* ws = (float*)(lds + OFF_WS) + wid * 64; float* li_l = ws; float* al_l = ws + 32;
  char* Qr_l = lds + OFF_QR + wid * 4096;
  const float* btab = (const float*)(lds + OFF_BT);
  float m_reg = -1e30f, l_reg = 0; f32x16 o[4] = {}; bf16x8 qr[8] = {}; i32x8 q8[3] = {};
  if constexpr (MODE != 0) {
    const bf16_t* Qw = Qb + (long)(wid * QBLK + r32) * LDQ + hi * 8;
#pragma unroll
    for (int d0 = 0; d0 < 8; ++d0) qr[d0] = ld8(Qw + d0 * 16);
  } else {
    const bf16_t* Qrow = Qb + (long)(wid * QBLK + r32) * LDQ;
#define BF2F(v) __uint_as_float(((unsigned)(unsigned short)(v)) << 16)
#pragma unroll
    for (int kb = 0; kb < 2; ++kb) { unsigned w[8];
#pragma unroll
      for (int c = 0; c < 4; ++c) { const bf16x8 x = ld8(Qrow + kb * 64 + hi * 32 + c * 8);
        w[2 * c] = pk4_fp8(BF2F(x[0]), BF2F(x[1]), BF2F(x[2]), BF2F(x[3])); w[2 * c + 1] = pk4_fp8(BF2F(x[4]), BF2F(x[5]), BF2F(x[6]), BF2F(x[7])); }
      q8[kb] = (i32x8){(int)w[0], (int)w[1], (int)w[2], (int)w[3], (int)w[4], (int)w[5], (int)w[6], (int)w[7]}; }
    { const f32x2* csr = cs + (long)(wid * QBLK + r32) * 32; unsigned w[8];
#pragma unroll
      for (int c = 0; c < 4; ++c) { const bf16x8 x1 = ld8(Qrow + 128 + c * 8), x2 = ld8(Qrow + 160 + c * 8); float r[8];
#pragma unroll
        for (int e = 0; e < 8; ++e) { const f32x2 t = csr[c * 8 + e]; const float a = BF2F(x1[e]), b = BF2F(x2[e]); r[e] = hi ? (b * t.x + a * t.y) : (a * t.x - b * t.y); }
        w[2 * c] = pk4_fp8(r[0], r[1], r[2], r[3]); w[2 * c + 1] = pk4_fp8(r[4], r[5], r[6], r[7]); }
      q8[2] = (i32x8){(int)w[0], (int)w[1], (int)w[2], (int)w[3], (int)w[4], (int)w[5], (int)w[6], (int)w[7]}; }
#undef BF2F
  }
  const int sr = tid >> 4, sc = (tid & 15) * 8, vst0 = v_st(sr, sc), vst1 = v_st(32 + sr, sc);
  const int krr = tid >> 3, krc = (tid & 7) * 8;
  const int kr0 = tid / 12, kc0 = tid - kr0 * 12, kr1 = (512 + tid) / 12, kc1 = (512 + tid) - kr1 * 12;
#define KAPPA(rho) ((((rho) >> 2) & 1) * 32 + (((rho) >> 5) & 1) * 16 + (((rho) & 3) | ((((rho) >> 3) & 3) << 2)))
  const int ks0r = KAPPA(kr0), ks1r = KAPPA(kr1), vd = tid >> 2, vch = tid & 3;
  const int vb0 = (int)(uintptr_t)V_lds + v_rd_base(lane);
  struct { bf16x8 vs0, vs1, ks0, ks1; } sr_[SD];
#define K8SRC(r_, c_, k0) ((c_) < 8 ? (const char*)Kh + (long)((k0) + (r_)) * 3072 + (c_) * 16 : (const char*)Krp + (long)((k0) + (r_)) * 64 + ((c_) - 8) * 16)
#define SLOAD(i, k0) do { \
    if constexpr (MODE == 0) { sr_[i].vs0 = *reinterpret_cast<const bf16x8*>((const char*)Vh + (long)vd * LDK + (k0) + vch * 16); \
      sr_[i].ks0 = *reinterpret_cast<const bf16x8*>(K8SRC(ks0r, kc0, k0)); if (tid < 256) sr_[i].ks1 = *reinterpret_cast<const bf16x8*>(K8SRC(ks1r, kc1, k0)); } \
    else { sr_[i].vs0 = ld8(&Vh[(long)((k0) + sr) * LDK + sc]); sr_[i].vs1 = ld8(&Vh[(long)((k0) + 32 + sr) * LDK + sc]); \
      sr_[i].ks0 = ld8(&Kh[(long)((k0) + sr) * LDK + sc]); sr_[i].ks1 = ld8(&Kh[(long)((k0) + 32 + sr) * LDK + sc]); } } while (0)
#define SWRITE(b, i) do { const int kc = sc * 2; \
    if constexpr (MODE == 0) { *(bf16x8*)(V_lds + (b) * SHM_V + vd * 80 + vch * 16) = sr_[i].vs0; \
      *(bf16x8*)(K_lds + (b) * SHM_K + kr0 * 208 + kc0 * 16) = sr_[i].ks0; if (tid < 256) *(bf16x8*)(K_lds + (b) * SHM_K + kr1 * 208 + kc1 * 16) = sr_[i].ks1; } \
    else { *(bf16x8*)(V_lds + (b) * SHM_V + vst0) = sr_[i].vs0; *(bf16x8*)(V_lds + (b) * SHM_V + vst1) = sr_[i].vs1; \
      *(bf16x8*)(K_lds + (b) * SHM_K + KSWZ(sr, kc)) = sr_[i].ks0; *(bf16x8*)(K_lds + (b) * SHM_K + KSWZ(32 + sr, kc)) = sr_[i].ks1; } } while (0)
#define PVC(voff) do { if constexpr (MODE == 0) pv8(o, V_lds + (voff), pa0, pa1, r32, hi); else pv_d0(o, vb0 + (voff), pa0, pa1, pa2, pa3); } while (0)
#define FSM(P0, P1, AL) do { if constexpr (MODE == 0) finishSM8(P0, P1, AL, l_reg, pa0, pa1); else finishSM(P0, P1, AL, l_reg, pa0, pa1, pa2, pa3); } while (0)
#define SWAIT() do { if constexpr (SD == 1) asm volatile("s_waitcnt vmcnt(0)" ::: "memory"); else if constexpr (MODE == 0) asm volatile("s_waitcnt vmcnt(5)" ::: "memory"); else asm volatile("s_waitcnt vmcnt(4)" ::: "memory"); } while (0)
#define SG_ONE(nds, nv, nt) do { __builtin_amdgcn_sched_group_barrier(0x008, 1, 0); __builtin_amdgcn_sched_group_barrier(0x100, nds, 0); \
    __builtin_amdgcn_sched_group_barrier(0x002, nv, 0); __builtin_amdgcn_sched_group_barrier(0x400, nt, 0); } while (0)
#define SG_QKT() do { if (SGQ) { __builtin_amdgcn_sched_group_barrier(0x100, SGQ_PRE, 0); if constexpr (MODE == 0) { _Pragma("unroll") for (int _g = 0; _g < 6; ++_g) SG_ONE(2, 12, 3); } else { _Pragma("unroll") for (int _g = 0; _g < 16; ++_g) SG_ONE(1, 5, 1); } } } while (0)
#define SG_PV() do { if (SGP) { __builtin_amdgcn_sched_group_barrier(0x100, SGP_PRE, 0); if constexpr (MODE == 0) { _Pragma("unroll") for (int _g = 0; _g < 4; ++_g) SG_ONE(2, 24, 4); } else { _Pragma("unroll") for (int _g = 0; _g < 16; ++_g) SG_ONE(2, 6, 1); } } } while (0)
#define RESC(a) do { if (__any((a) < 1.f)) { if (hi == 0) al_l[r32] = (a); asm volatile("s_waitcnt lgkmcnt(0)" ::: "memory"); \
    _Pragma("unroll") for (int d = 0; d < 4; ++d) _Pragma("unroll") for (int r = 0; r < 16; ++r) o[d][r] *= al_l[crow(r, hi)]; } } while (0)
  f32x16 pA0, pA1, pB0, pB1; float mnA, mnB, alA, alB; bf16x8 pa0, pa1, pa2 = {}, pa3 = {};
  const int kbl = kbw - wid * QBLK - r32 + 4 * hi;
  constexpr int SE = 0, SO = SD - 1;
  SLOAD(SE, 0); asm volatile("s_waitcnt vmcnt(0)" ::: "memory"); SWRITE(0, SE); __syncthreads();
  qkt<MODE>(pA0, pA1, K_lds, Kr_lds, Qr_l, qr, q8, r32, hi); partialSM<MODE>(pA0, pA1, m_reg, mnA, alA, C, kbl, btab, nomask);
  SLOAD(SO, KVBLK); if constexpr (SD == 2) { if (2 < NT) SLOAD(SE, 2 * KVBLK); }
  SWAIT(); SWRITE(1, SO); __syncthreads();
  for (int j = 1; j + 1 < NT; j += 2) {
    SBAR(); qkt<MODE>(pB0, pB1, K_lds + SHM_K, Kr_lds + SHM_KR, Qr_l, qr, q8, r32, hi);
    FSM(pA0, pA1, alA); SG_QKT(); SBAR();
    SLOAD(SO, (j + SD) * KVBLK); SBAR();
    PVC(0); partialSM<MODE>(pB0, pB1, m_reg, mnB, alB, C, kbl + j * KVBLK, btab, nomask); asm volatile("" : "+v"(pB0), "+v"(pB1), "+v"(alB)); SG_PV(); SBAR();
    __syncthreads(); SWAIT(); SWRITE(0, SE);
    RESC(alB); __syncthreads();
    SBAR(); qkt<MODE>(pA0, pA1, K_lds, Kr_lds, Qr_l, qr, q8, r32, hi);
    FSM(pB0, pB1, alB); SG_QKT(); SBAR();
    if (SD == 1 || j + 3 < NT) SLOAD(SE, (j + 1 + SD) * KVBLK); SBAR();
    PVC(SHM_V); partialSM<MODE>(pA0, pA1, m_reg, mnA, alA, C, kbl + (j + 1) * KVBLK, btab, nomask); asm volatile("" : "+v"(pA0), "+v"(pA1), "+v"(alA)); SG_PV(); SBAR();
    __syncthreads(); SWAIT(); SWRITE(1, SO);
    RESC(alA); __syncthreads();
  }
  SBAR(); qkt<MODE>(pB0, pB1, K_lds + SHM_K, Kr_lds + SHM_KR, Qr_l, qr, q8, r32, hi);
  FSM(pA0, pA1, alA); SBAR();
  PVC(0); partialSM<MODE>(pB0, pB1, m_reg, mnB, alB, C, kbl + (NT - 1) * KVBLK, btab, nomask);
  __syncthreads(); RESC(alB);
  FSM(pB0, pB1, alB); SBAR();
  PVC(SHM_V);
  if constexpr (MODE == 1) l_reg += __builtin_amdgcn_exp2f(sink_l2 - m_reg);
  if (hi == 0) li_l[r32] = l_reg; asm volatile("s_waitcnt lgkmcnt(0)" ::: "memory");
  float rli[16];
#pragma unroll
  for (int r = 0; r < 16; ++r) rli[r] = __builtin_amdgcn_rcpf(li_l[crow(r, hi)]);
  bf16_t* Ow = Ob + (long)(wid * QBLK) * LDO;
#pragma unroll
  for (int r = 0; r < 16; ++r) { const int orow = crow(r, hi);
#pragma unroll
    for (int d0 = 0; d0 < 4; ++d0) Ow[(long)orow * LDO + d0 * 32 + r32] = (bf16_t)(cvtpk(o[d0][r] * rli[r], 0.f) & 0xffffu); }
  if (ATT_PRIO) __builtin_amdgcn_s_setprio(0);
#undef SG_ONE
#undef SG_QKT
#undef SG_PV
#undef SLOAD
#undef K8SRC
#undef KAPPA
#undef PVC
#undef FSM
#undef SWRITE
#undef SWAIT
#undef RESC
}
}

#define RLX_AGENT __ATOMIC_RELAXED, __HIP_MEMORY_SCOPE_AGENT
#define XB_TMO      128
#define XB_XCNT(j)  (256  + 64 * (j))
#define XB_XSUB(j)  (1280 + 64 * (j))
#define XB_XGEN(j)  (2304 + 64 * (j))
#define XB_TOP      3328
#define XB_TOPGEN   3392
#define XCD_BAR_WORDS 3456
#define XB_SPIN_CAP (1u << 18)

__device__ __forceinline__ unsigned xb_ld(unsigned* p)              { return __hip_atomic_load(p, __ATOMIC_RELAXED, __HIP_MEMORY_SCOPE_AGENT); }
__device__ __forceinline__ unsigned xb_add(unsigned* p, unsigned v) { return __hip_atomic_fetch_add(p, v, __ATOMIC_RELAXED, __HIP_MEMORY_SCOPE_AGENT); }
__device__ __forceinline__ unsigned xb_xcc_id() { return (unsigned)__builtin_amdgcn_s_getreg((3 << 11) | 20) & 0xFu; }
#define XB_SPIN(cond, bar) do { unsigned _sp = 0; while (cond) { __builtin_amdgcn_s_sleep(1); \
    if ((++_sp & 255u) == 0u) { if (xb_ld(&(bar)[XB_TMO])) break; if (_sp > XB_SPIN_CAP) { atomicAdd(&(bar)[XB_TMO], 1u); break; } } } } while (0)

struct XcdBarrier {
    unsigned* bar; unsigned x;
    volatile LAS unsigned* st;
};

__device__ __forceinline__ XcdBarrier xcd_barrier_post(unsigned* bar, volatile LAS unsigned* st) {
    XcdBarrier b; b.bar = bar; b.x = xb_xcc_id(); b.st = st;
    if (threadIdx.x == 0) (void)xb_add(&bar[XB_XCNT(b.x)], 1u);
    return b;
}
__device__ __forceinline__ void xcd_barrier_complete(unsigned* bar, unsigned x, unsigned& nloc, unsigned& nx) {
    const unsigned G = gridDim.x * gridDim.y * gridDim.z;
    unsigned sum, cnt, mine, sp = 0u;
    for (;;) {
        sum = 0u; cnt = 0u; mine = 0u;
#pragma unroll
        for (unsigned j = 0; j < 16; ++j) { const unsigned c = xb_ld(&bar[XB_XCNT(j)]); sum += c; cnt += (c > 0u) ? 1u : 0u; mine = (j == x) ? c : mine; }
        if (sum == G) break;
        __builtin_amdgcn_s_sleep(1);
        if ((++sp & 255u) == 0u) { if (xb_ld(&bar[XB_TMO])) break; if (sp > XB_SPIN_CAP) { atomicAdd(&bar[XB_TMO], 1u); break; } }
    }
    nloc = mine > 0u ? mine : 1u; nx = cnt > 0u ? cnt : 1u;
}

__device__ __forceinline__ void xcd_barrier(const XcdBarrier& b) {
    asm volatile("s_waitcnt vmcnt(0)" ::: "memory");
    __syncthreads();
    if (threadIdx.x == 0) {
        unsigned* bar = b.bar;
        __builtin_amdgcn_s_waitcnt(0);
        unsigned nloc = b.st[0], nx = b.st[1];
        if (nloc == 0u) { xcd_barrier_complete(bar, b.x, nloc, nx); b.st[0] = nloc; b.st[1] = nx; }
        const unsigned old = xb_add(&bar[XB_XSUB(b.x)], 1u);
        const unsigned gen = old / nloc;
        if (old + 1u == (gen + 1u) * nloc) {
            __builtin_amdgcn_fence(__ATOMIC_RELEASE, "agent");
            asm volatile("s_waitcnt vmcnt(0)" ::: "memory");
            const unsigned og = xb_add(&bar[XB_TOP], 1u);
            const unsigned tg = og / nx;
            if (og + 1u == (tg + 1u) * nx) xb_add(&bar[XB_TOPGEN], 1u);
            else XB_SPIN(xb_ld(&bar[XB_TOPGEN]) == tg, bar);
            __builtin_amdgcn_fence(__ATOMIC_ACQUIRE, "agent");
            xb_add(&bar[XB_XGEN(b.x)], 1u);
            asm volatile("s_waitcnt vmcnt(0)" ::: "memory");
        } else {
            XB_SPIN(xb_ld(&bar[XB_XGEN(b.x)]) == gen, bar);
            __builtin_amdgcn_fence(__ATOMIC_ACQUIRE, "agent");
            asm volatile("s_waitcnt vmcnt(0)" ::: "memory");
        }
    }
    __syncthreads();
}


struct Args {
    const float* in[24];
    float* out; unsigned char* ws;
    float inv_freq[32];
    int never, pad;
};

__device__ __forceinline__ float wave_sum(float v) {
#pragma unroll
    for (int o = 1; o < 64; o <<= 1) v += __shfl_xor(v, o);
    return v;
}
__device__ __forceinline__ unsigned f2bf(float f) { unsigned u = __builtin_bit_cast(unsigned, f); return (u + 0x7fffu + ((u >> 16) & 1u)) >> 16; }
__device__ __forceinline__ unsigned pk2(float lo, float hi) { return f2bf(lo) | (f2bf(hi) << 16); }

template <bool F8 = false>
__device__ __forceinline__ void tr_item(const float* __restrict__ W, int K, int N, bf16_t* __restrict__ WT, int dst_row, int k0, int n0, LAS float* scr, int lane, const float* __restrict__ ksc, int ldt = 0, int koff = 0) {
    if (ldt == 0) ldt = K;
    {
        float v[32];
#pragma unroll
        for (int i = 0; i < 32; ++i) v[i] = W[(size_t)(k0 + 2 * i + (lane >> 5)) * N + n0 + (lane & 31)];
        if (ksc) {
#pragma unroll
            for (int i = 0; i < 32; ++i) v[i] *= ksc[k0 + 2 * i + (lane >> 5)];
        }
#pragma unroll
        for (int i = 0; i < 32; ++i) scr[(2 * i + (lane >> 5)) * 33 + (lane & 31)] = v[i];
    }
    asm volatile("s_waitcnt lgkmcnt(0)" ::: "memory");
    const int c = lane & 7;
#pragma unroll
    for (int j = 0; j < 4; ++j) { const int n = (lane >> 3) + 8 * j; const LAS float* s = scr + (8 * c) * 33 + n;
        if constexpr (F8) { u32x2 o8; o8.x = pk4_fp8(s[0 * 33] * 64.f, s[1 * 33] * 64.f, s[2 * 33] * 64.f, s[3 * 33] * 64.f); o8.y = pk4_fp8(s[4 * 33] * 64.f, s[5 * 33] * 64.f, s[6 * 33] * 64.f, s[7 * 33] * 64.f);
            *(u32x2*)((unsigned char*)WT + (size_t)(dst_row + n) * ldt + koff + k0 + 8 * c) = o8; }
        else { u32x4 o; o.x = pk2(s[0 * 33], s[1 * 33]); o.y = pk2(s[2 * 33], s[3 * 33]); o.z = pk2(s[4 * 33], s[5 * 33]); o.w = pk2(s[6 * 33], s[7 * 33]);
            *(u32x4*)(WT + (size_t)(dst_row + n) * ldt + koff + k0 + 8 * c) = o; } }
    asm volatile("s_waitcnt lgkmcnt(0)" ::: "memory");
}

template <bool STATS>
__device__ __forceinline__ void ln_row(const float* xin, float* xout, bf16_t* bout, const float* __restrict__ g, const float* __restrict__ b, int lane, f32x2* st) {
    f32x4 v[8]; float s = 0.f;
#pragma unroll
    for (int j = 0; j < 8; ++j) { v[j] = *(const f32x4*)(xin + (lane + 64 * j) * 4); s += (v[j].x + v[j].y) + (v[j].z + v[j].w); }
    const float mean = wave_sum(s) * (1.f / DM); float s2 = 0.f;
#pragma unroll
    for (int j = 0; j < 8; ++j) { v[j] = v[j] - mean; s2 += (v[j].x * v[j].x + v[j].y * v[j].y) + (v[j].z * v[j].z + v[j].w * v[j].w); }
    const float rstd = 1.f / sqrtf(wave_sum(s2) * (1.f / DM) + 1e-5f);
    if constexpr (STATS) { if (lane == 0) *st = (f32x2){mean, rstd}; }
#pragma unroll
    for (int j = 0; j < 8; ++j) { const int c = (lane + 64 * j) * 4; const f32x4 gg = *(const f32x4*)(g + c), bb = *(const f32x4*)(b + c);
        const f32x4 o = v[j] * rstd * gg + bb;
        if constexpr (STATS) { u32x2 w; w.x = cvt_pk_bf16(o.x, o.y); w.y = cvt_pk_bf16(o.z, o.w); *(u32x2*)(bout + c) = w; }
        else *(f32x4*)(xout + c) = o; }
}

constexpr int LDS_BYTES = 148480;
constexpr int N_ATT_UNITS = 768 + 192 + 960 + 640;

__global__ void __launch_bounds__(512) fwd_megakernel(Args args) {
    extern __shared__ __attribute__((aligned(16))) unsigned char lds_raw[];
    cg::grid_group grid = cg::this_grid();
    LAS unsigned char* lds = (LAS unsigned char*)lds_raw;
    const int tid = threadIdx.x, lane = tid & 63, wave = __builtin_amdgcn_readfirstlane(tid >> 6);
    const int G = gridDim.x, bx = blockIdx.x;
#define ws (args.ws)
#define x_prompt (args.in[0])
#define x_sample (args.in[1])
#define W1T ((bf16_t*)(ws + WS_W1T))
#define WLAT ((bf16_t*)(ws + WS_WLAT))
#define WBA ((bf16_t*)(ws + WS_WBA))
#define WBB ((bf16_t*)(ws + WS_WBB))
#define WBC ((bf16_t*)(ws + WS_WBC))
#define WOT ((bf16_t*)(ws + WS_WO))
#define WFI ((bf16_t*)(ws + WS_WFI))
#define WFD ((bf16_t*)(ws + WS_WFD))
#define ROPE ((f32x2*)(ws + WS_ROPE))
#define MKV ((bf16_t*)(ws + WS_MKV))
#define RSTD ((float*)(ws + WS_RSTD))
#define KROPE ((bf16_t*)(ws + WS_KROPE))
#define XB ((bf16_t*)(ws + WS_R1))
#define AOUT ((bf16_t*)(ws + WS_R1 + R1_AOUT))
#define BOUT ((bf16_t*)(ws + WS_R1 + R1_BOUT))
#define COUT ((bf16_t*)(ws + WS_R1 + R1_COUT))
#define HB XB
#define GATES ((bf16_t*)(ws + WS_R2))
#define ACT GATES
#define QB ((bf16_t*)(ws + WS_R3 + R3_QB))
#define KVB ((bf16_t*)(ws + WS_R3 + R3_KVB))
#define XM ((bf16_t*)(ws + WS_R3))
#define PROJ ((bf16_t*)args.out)
#define OUT (args.out)
#define CTL ((unsigned*)(ws + WS_CTL))
    const int gw = bx * 8 + wave, NGW = G * 8;
    volatile LAS unsigned* MISC = (volatile LAS unsigned*)(lds + (LDS_BYTES - 64));
    if (tid < 16) MISC[tid] = 0u;
    __syncthreads();
    XcdBarrier xbar = xcd_barrier_post(CTL + 4096, MISC + 8);

    {
        LAS float* scr = (LAS float*)(lds + wave * 16384);
        constexpr int I0 = 32 * 90, I1 = 32 * 192, I2 = 32 * 32, I3 = 8 * 36, I4 = 8 * 48, I5 = 12 * 64, I6 = 12 * 64, I7 = 8 * 64, I8 = 32 * 64, I9 = 32 * 352, I10 = 88 * 64;
        constexpr int NIT = I0 + I1 + I2 + I3 + I4 + I5 + I6 + I7 + I8 + I9 + I10;
        for (int it = gw; it < NIT; it += NGW) {
            int r = it;
            if (r < I0) { const int kb = r / 90, nb = r % 90, n0 = nb * 32; const int dst = n0 < 2304 ? n0 : (n0 < 2368 ? n0 + 512 : n0 - 64);
                tr_item(args.in[4], 2048, 2880, W1T, dst, kb * 64, n0, scr, lane, nullptr); continue; } r -= I0;
            if (r < I1) { const int kb = r / 192, nb = r % 192; tr_item<true>(args.in[12], 2048, 6144, W1T + (size_t)NPROJ * DM  , nb * 32, kb * 64, nb * 32, scr, lane, nullptr); continue; } r -= I1;
            if (r < I2) { const int kb = r / 32, nb = r % 32; tr_item(args.in[11], 2048, 1024, W1T, NPROJ + NGATE + nb * 32, kb * 64, nb * 32, scr, lane, nullptr); continue; } r -= I2;
            if (r < I3) { const int kb = r / 36, nb = r % 36; tr_item(args.in[8], 512, 1152, WLAT, nb * 32, kb * 64, nb * 32, scr, lane, args.in[7]); continue; } r -= I3;
            if (r < I4) { const int kb = r / 48, nb = r % 48; tr_item(args.in[10], 512, 1536, WLAT, LDQB + nb * 32, kb * 64, nb * 32, scr, lane, args.in[9]); continue; } r -= I4;
            if (r < I5) { const int kb = r / 64, nb = r % 64; tr_item(args.in[14], 768, 2048, WBA, nb * 32, kb * 64, nb * 32, scr, lane, nullptr, DM, 0); continue; } r -= I5;
            if (r < I6) { const int kb = r / 64, nb = r % 64; tr_item(args.in[15], 768, 2048, WBA, nb * 32, kb * 64, nb * 32, scr, lane, nullptr, DM, 768); continue; } r -= I6;
            if (r < I7) { const int kb = r / 64, nb = r % 64; tr_item(args.in[16], 512, 2048, WBA, nb * 32, kb * 64, nb * 32, scr, lane, nullptr, DM, 1536); continue; } r -= I7;
            if (r < I8) { const int kb = r / 64, nb = r % 64; tr_item(args.in[17], 2048, 2048, WOT, nb * 32, kb * 64, nb * 32, scr, lane, nullptr); continue; } r -= I8;
            if (r < I9) { const int kb = r / 352, nb = r % 352, n0 = nb * 32; const int j = n0 < DFF ? n0 : n0 - DFF; const int dst = (j / 128) * 256 + (n0 < DFF ? 0 : 128) + (j % 128);
                tr_item(args.in[20], 2048, 2 * DFF, WFI, dst, kb * 64, n0, scr, lane, nullptr); continue; } r -= I9;
            { const int kb = r / 64, nb = r % 64; tr_item(args.in[21], DFF, 2048, WFD, nb * 32, kb * 64, nb * 32, scr, lane, nullptr); }
        }
        const long gt = (long)bx * 512 + tid, NGT = (long)G * 512;
        constexpr long NX8 = (long)(T_TOK + 768) * DM / 8;
        for (long i = gt; i < NX8; i += NGT) { const long e = i * 8; const float* src;
            if (e < (long)T_PROMPT * DM) src = x_prompt + e; else if (e < (long)T_TOK * DM) src = x_sample + (e - (long)T_PROMPT * DM);
            else if (e < (long)(T_TOK + 512) * DM) src = args.in[2] + (e - (long)T_TOK * DM); else src = args.in[3] + (e - (long)(T_TOK + 512) * DM);
            const f32x4 a = *(const f32x4*)src, b = *(const f32x4*)(src + 4);
            *(u32x4*)(XB + e) = pg8::pack8(a, b);
            if (e < (long)T_TOK * DM) { u32x2 o8; o8.x = pk4_fp8(a[0], a[1], a[2], a[3]); o8.y = pk4_fp8(b[0], b[1], b[2], b[3]); *(u32x2*)((unsigned char*)(ws + WS_R3) + e) = o8; } }
        for (long i = gt; i < (long)SEQ_P * 32; i += NGT) { const int pos = (int)(i >> 5), j = (int)(i & 31);
            const float ang = (float)pos * args.inv_freq[j];
            const double rev = (double)ang * 0.15915494309189535; const float fr = (float)(rev - floor(rev));
            ROPE[i] = (f32x2){__builtin_amdgcn_cosf(fr), __builtin_amdgcn_sinf(fr)}; }
    }
    if (args.never) grid.sync();
    xcd_barrier(xbar);

    for (int rep = 0; rep < REP_SYNC; ++rep) xcd_barrier(xbar);
    {
        pg8::Gemm g{XB, W1T, DM, DM}; pg8::Order1 S{G, bx};
        pg8::EpiProj E{PROJ, GATES, MKV, args.in[13]};
        pg8::gemm_phase<pg8::EpiProj, pg8::Order1>(lds, g, S, E);
    }
    {
        pg8::Gemm g8{(const bf16_t*)(ws + WS_R3), W1T + (size_t)NPROJ * DM, DM / 2, DM / 2}; pg8::StaticOrder S8; S8.init(T_TOK, NGATE, G, bx);
        pg8::EpiGate E8{GATES, args.in[13]};
        pg8::gemm_phase<pg8::EpiGate, pg8::StaticOrder, true>(lds, g8, S8, E8);
    }
    xcd_barrier(xbar);

    for (int m0 = gw * P2R; m0 < T_TOK; m0 += NGW * P2R) {
        u32x4 a[P2R], b[P2R]; float x1[P2R], x2[P2R]; f32x2 cs4[P2R];
#pragma unroll
        for (int i = 0; i < P2R; ++i) { const int m = m0 + i; const bf16_t* pr = PROJ + (size_t)m * NPROJ;
            a[i] = *(const u32x4*)(pr + C_CQ + lane * 8); b[i] = *(const u32x4*)(pr + C_CKV + lane * 8);
            const int pos = m < T_PROMPT ? (m & (SEQ_P - 1)) : (m - T_PROMPT);
            x1[i] = bf_lo((unsigned)pr[C_KR + (lane & 31)]); x2[i] = bf_lo((unsigned)pr[C_KR + 32 + (lane & 31)]); cs4[i] = ROPE[(size_t)pos * 32 + (lane & 31)]; }
#pragma unroll
        for (int i = 0; i < P2R; ++i) { const int m = m0 + i; float sa = 0.f, sb = 0.f;
#pragma unroll
            for (int e = 0; e < 4; ++e) { const float a0 = bf_lo(a[i][e]), a1 = bf_hi(a[i][e]), b0 = bf_lo(b[i][e]), b1 = bf_hi(b[i][e]); sa += a0 * a0 + a1 * a1; sb += b0 * b0 + b1 * b1; }
            sa = wave_sum(sa); sb = wave_sum(sb);
            if (lane == 0) { RSTD[m * 2] = 1.f / sqrtf(sa * (1.f / 512.f) + 1e-6f); RSTD[m * 2 + 1] = 1.f / sqrtf(sb * (1.f / 512.f) + 1e-6f); }
            if (lane < 32) { const float r1 = x1[i] * cs4[i].x - x2[i] * cs4[i].y, r2 = x2[i] * cs4[i].x + x1[i] * cs4[i].y; const unsigned pk = pk4_fp8(r1, r2, 0.f, 0.f);
                unsigned char* kr8 = (unsigned char*)KROPE + (size_t)m * 64; kr8[lane] = (unsigned char)(pk & 0xffu); kr8[32 + lane] = (unsigned char)((pk >> 8) & 0xffu); } }
    }
    xcd_barrier(xbar);

    {
        pg8::Gemm g{PROJ + C_CQ, WLAT, NPROJ, 512}; pg8::Order23 S{G, bx};
        pg8::EpiLat E{QB, KVB, RSTD, lds, (unsigned char*)args.out + (size_t)T_TOK * NPROJ * 2  };
        pg8::gemm_phase<pg8::EpiLat, pg8::Order23>(lds, g, S, E);
    }
    xcd_barrier(xbar);

    {
        char* shm = (char*)lds_raw;
        volatile unsigned* idxw = (volatile unsigned*)(shm + att::OFF_IDX);
        float* btab = (float*)(shm + att::OFF_BT);
        for (int rep = 0; rep < REP_ATT; ++rep)
        for (;;) {
            __syncthreads();
            if (tid == 0) *idxw = atomicAdd(CTL + 64 + 64 * rep, 1u);
            __syncthreads();
            const int u = (int)*idxw;
            if (u >= N_ATT_UNITS) break;
            if (u < 960) {
                int sq, h, qb, len, rowbase;
                if (u < 768) { sq = u / 384; const int rem = u % 384; h = rem / 64; qb = rem % 64; len = SEQ_P; rowbase = sq * SEQ_P; }
                else { const int v = u - 768; h = v / 32; qb = v % 32; len = SEQ_S; rowbase = T_PROMPT; }
                const long q0 = (long)rowbase + qb * 256;
                att::attn_body<0, 1>(QB + q0 * LDQB + h * 192, (const bf16_t*)((const char*)KVB + (long)rowbase * (LDKVB * 2) + h * 512)  , (const bf16_t*)((const char*)args.out + (size_t)T_TOK * NPROJ * 2 + (size_t)(rowbase / SEQ_P) * (6 * 128 * SEQ_P) + (size_t)h * 128 * len)  , (const bf16_t*)((const char*)KROPE + (long)rowbase * 64)  ,
                                     AOUT + q0 * DM + 768 + h * 128, len / 64, 0.07216878364870322f * LOG2E, ROPE + (long)qb * 256 * 32, 0, 0.f, false, LDQB, len, DM, shm);
            } else {
                const bf16_t *Qp, *Kp, *Vp; bf16_t* Op; int NT, kbw, ldk, ldo; float sink; bool nomask;
                if (u < 1920) {
                    const int v = u - 960, t256 = v / 6, h = v % 6, kvh = h / 3;
                    const long q0 = (long)t256 * 256;
                    const int rowbase = q0 < T_PROMPT ? (int)(q0 & ~(long)(SEQ_P - 1)) : T_PROMPT; const int len = q0 < T_PROMPT ? SEQ_P : SEQ_S;
                    const int ql = (int)(q0 - rowbase);
                    const int ks = ql - 128 < 0 ? 0 : ql - 128; const int ke = ql + 384 > len ? len : ql + 384;
                    if (tid < 257) { const int rel = tid - 128; const int n = rel < 0 ? -rel : rel;
                        const int large = 8 + (n >= 12) + (n >= 16) + (n >= 23) + (n >= 32) + (n >= 46) + (n >= 64) + (n >= 91);
                        const int bucket = (rel > 0 ? 16 : 0) + (n < 8 ? n : large);
                        btab[tid] = args.in[5][bucket * 6 + h] * LOG2E; }
                    const long k0 = (long)rowbase + ks;
                    Qp = PROJ + q0 * NPROJ + C_QA + h * 128; Kp = PROJ + k0 * NPROJ + C_KA + kvh * 128; Vp = PROJ + k0 * NPROJ + C_VA + kvh * 128; Op = AOUT + q0 * DM + h * 128;
                    NT = (ke - ks) / 64; kbw = ks - ql + 128; ldk = NPROJ; ldo = DM; sink = args.in[6][h] * LOG2E; nomask = false;
                } else {
                    const int v = u - 1920, t256 = v / 4, h = v % 4;
                    const long q0 = (long)t256 * 256;
                    const int bi = q0 < T_PROMPT ? (int)(q0 / SEQ_P) : 2;
                    if (tid == 0) btab[257] = 0.f;
                    Qp = PROJ + q0 * NPROJ + C_QC + h * 128; Kp = MKV + (long)bi * 256 * NMKV + h * 128; Vp = Kp + 512; Op = AOUT + q0 * DM + 1536 + h * 128;
                    NT = 4; kbw = 0; ldk = NMKV; ldo = DM; sink = -1e30f; nomask = true;
                }
                att::attn_body<1, 1>(Qp, Kp, Vp, nullptr, Op, NT, 0.08838834764831845f * LOG2E, nullptr, kbw, sink, nomask, NPROJ, ldk, ldo, shm);
            }
        }
    }
    xcd_barrier(xbar);

    {
        pg8::StaticOrder S; S.init(T_TOK, DM, G, bx);
        { pg8::Gemm g{AOUT, WBA, DM, DM}; pg8::OrderMerge SM{G, bx}; pg8::EpiMergeF E{XM, GATES}; pg8::gemm_phase<pg8::EpiMergeF, pg8::OrderMerge>(lds, g, SM, E); }
        xcd_barrier(xbar);
        { pg8::Gemm g{XM, WOT, DM, DM}; pg8::EpiRes E{x_prompt, x_sample, OUT}; pg8::gemm_phase<pg8::EpiRes, pg8::StaticOrder>(lds, g, S, E); }
    }
    xcd_barrier(xbar);
    { int t2 = threadIdx.x; asm volatile("" : "+v"(t2)); const int lane2 = t2 & 63;
      for (int m = gw; m < T_TOK; m += NGW) ln_row<true>(OUT + (size_t)m * DM, nullptr, HB + (size_t)m * DM, args.in[18], args.in[19], lane2, (f32x2*)RSTD + m); }
    xcd_barrier(xbar);
    {
        pg8::StaticOrder S; S.init(T_TOK, 2 * DFF, G, bx);
        pg8::Gemm g{HB, WFI, DM, DM}; pg8::EpiSwiglu E{ACT}; for (int rep = 0; rep < REP_FFI; ++rep) pg8::gemm_phase<pg8::EpiSwiglu, pg8::StaticOrder>(lds, g, S, E);
    }
    xcd_barrier(xbar);
    {
        pg8::StaticOrder S; S.init(T_TOK, DM, G, bx);
        pg8::Gemm g{ACT, WFD, DFF, DFF}; pg8::EpiResLN E{OUT, (const f32x2*)RSTD, args.in[18], args.in[19]}; pg8::gemm_phase<pg8::EpiResLN, pg8::StaticOrder>(lds, g, S, E);
    }
    xcd_barrier(xbar);
    { int t2 = threadIdx.x; asm volatile("" : "+v"(t2)); const int lane2 = t2 & 63;
      for (int m = gw; m < T_TOK; m += NGW) ln_row<false>(OUT + (size_t)m * DM, OUT + (size_t)m * DM, nullptr, args.in[22], args.in[23], lane2, nullptr); }
}

#undef ws
#undef x_prompt
#undef x_sample
#undef W1T
#undef WLAT
#undef WBA
#undef WBB
#undef WBC
#undef WOT
#undef WFI
#undef WFD
#undef ROPE
#undef MKV
#undef RSTD
#undef KROPE
#undef XB
#undef AOUT
#undef BOUT
#undef COUT
#undef HB
#undef GATES
#undef ACT
#undef QB
#undef KVB
#undef XM
#undef PROJ
#undef OUT
#undef CTL

extern "C" void kernel_launch(void* const* d_in, const int* in_sizes, int n_in, void* d_out, int out_size, void* d_ws, size_t ws_size, hipStream_t stream) {
    static int grid = 0;
    if (grid == 0) {
        if (n_in != 24 || out_size != T_TOK * DM || ws_size < WS_END) { fprintf(stderr, "kernel_launch: unexpected shapes (n_in %d out %d ws %zu)\n", n_in, out_size, ws_size); grid = -1; return; }
        int dev = 0, cus = 0, per_cu = 0;
        hipGetDevice(&dev); hipDeviceGetAttribute(&cus, hipDeviceAttributeMultiprocessorCount, dev);
        if (hipFuncSetAttribute((const void*)fwd_megakernel, hipFuncAttributeMaxDynamicSharedMemorySize, LDS_BYTES) != hipSuccess) { fprintf(stderr, "kernel_launch: hipFuncSetAttribute failed\n"); grid = -1; return; }
        if (hipOccupancyMaxActiveBlocksPerMultiprocessor(&per_cu, (const void*)fwd_megakernel, 512, LDS_BYTES) != hipSuccess || per_cu < 1) { fprintf(stderr, "kernel_launch: occupancy query says %d\n", per_cu); per_cu = 1; }
        (void)hipGetLastError();
        grid = cus;
    }
    if (grid < 0) return;
    hipMemsetAsync((char*)d_ws + WS_CTL, 0, 65536, stream);
    Args a{};
    for (int i = 0; i < 24; ++i) a.in[i] = (const float*)d_in[i];
    a.out = (float*)d_out; a.ws = (unsigned char*)d_ws;
    for (int j = 0; j < 32; ++j) { const float e = (float)j / 32.0f; const float p = powf(10000.0f, e); a.inv_freq[j] = 1.0f / p; }
    void* kargs[] = {&a};
    hipError_t e = hipLaunchCooperativeKernel((const void*)fwd_megakernel, dim3(grid), dim3(512), kargs, LDS_BYTES, stream);
    if (e != hipSuccess) fprintf(stderr, "cooperative launch failed: %s (grid %d)\n", hipGetErrorString(e), grid);
}
```

```cpp
#include <hip/hip_runtime.h>
#include <hip/hip_cooperative_groups.h>
#include <cstdio>
#include <cstdint>
#include <cmath>
namespace cg = cooperative_groups;
#ifndef SGQ
#define SGQ 1
#endif
#ifndef SGP
#define SGP 1
#endif
#ifndef SGQ_PRE
#define SGQ_PRE 3
#endif
#ifndef SGP_PRE
#define SGP_PRE 4
#endif
#ifndef HOOKB
#define HOOKB 4
#endif
#ifndef REP_SYNC
#define REP_SYNC 0
#endif
#ifndef ATT_PRIO
#define ATT_PRIO 1
#endif
#ifndef P2R
#define P2R 4
#endif
#ifndef REP_ATT
#define REP_ATT 1
#endif
#ifndef REP_FFI
#define REP_FFI 1
#endif
#ifndef REP_G1
#define REP_G1 1
#endif

#define LAS __attribute__((address_space(3)))
typedef unsigned short bf16_t;
typedef short bf16x8 __attribute__((ext_vector_type(8)));
typedef short s16x4 __attribute__((ext_vector_type(4)));
typedef float f32x4 __attribute__((ext_vector_type(4)));
typedef float f32x2 __attribute__((ext_vector_type(2)));
typedef float f32x16 __attribute__((ext_vector_type(16)));
typedef unsigned u32x4 __attribute__((ext_vector_type(4)));
typedef unsigned u32x2 __attribute__((ext_vector_type(2)));
typedef int i32x8 __attribute__((ext_vector_type(8)));

constexpr int DM = 2048, T_TOK = 40960, T_PROMPT = 32768, SEQ_P = 16384, SEQ_S = 8192;
constexpr int NPROJ = 3072;
constexpr int C_QA = 0, C_KA = 768, C_VA = 1024, C_CQ = 1280, C_CKV = 1792, C_QC = 2304, C_KR = 2816;
constexpr int NGATE = 6144, NMKV = 1024, N1 = NPROJ + NGATE + NMKV;
constexpr int LDQB = 1280, LDKVB = 1536, NLAT = LDQB + LDKVB;
constexpr int DFF = 5632;
constexpr float ALPHA = 1.189207115002721f;
constexpr float LOG2E = 1.4426950408889634f;

constexpr size_t MiB = 1u << 20;
constexpr size_t WS_CTL = 0;
constexpr size_t WS_W1T = 1 * MiB, WS_WLAT = 41 * MiB, WS_WBA = 44 * MiB, WS_WBB = 47 * MiB, WS_WBC = 50 * MiB, WS_WO = 52 * MiB, WS_WFI = 60 * MiB, WS_WFD = 104 * MiB;
constexpr size_t WS_ROPE = 126 * MiB, WS_MKV = 130 * MiB, WS_RSTD = 132 * MiB, WS_KROPE = 133 * MiB;
constexpr size_t WS_R1 = 138 * MiB;
constexpr size_t WS_R2 = 302 * MiB;
constexpr size_t WS_R3 = 782 * MiB;
constexpr size_t WS_END = 1002 * MiB;
constexpr size_t R1_AOUT = 0, R1_BOUT = (size_t)T_TOK * 768 * 2, R1_COUT = (size_t)T_TOK * 1536 * 2;
constexpr size_t R3_QB = 0, R3_KVB = (size_t)T_TOK * LDQB * 2;

__device__ __forceinline__ unsigned cvt_pk_bf16(float lo, float hi) { unsigned r; asm volatile("v_cvt_pk_bf16_f32 %0, %1, %2" : "=v"(r) : "v"(lo), "v"(hi)); return r; }
__device__ __forceinline__ float bf_lo(unsigned u) { return __uint_as_float(u << 16); }
__device__ __forceinline__ float bf_hi(unsigned u) { return __uint_as_float(u & 0xffff0000u); }
__device__ __forceinline__ unsigned pk4_fp8(float a, float b, float c, float d) { int p = __builtin_amdgcn_cvt_pk_fp8_f32(a, b, 0, false); p = __builtin_amdgcn_cvt_pk_fp8_f32(c, d, p, true); return (unsigned)p; }
__device__ __forceinline__ float sigmoidf_(float v) { return __builtin_amdgcn_rcpf(1.0f + __builtin_amdgcn_exp2f(-v * LOG2E)); }

namespace pg8 {
constexpr int BM = 256, BK = 64, HALF = 128, HTB = HALF * BK * 2, STAGE_BYTES = 8 * HTB, NXCD = 8;
__device__ __forceinline__ int lds_byte(int r, int c) { const int st = (r >> 4) * 2 + (c >> 5), rr = r & 15, cc = c & 31, ob = rr * 64 + cc * 2; return st * 1024 + (ob ^ (((ob >> 9) & 1) << 5)); }
__device__ __forceinline__ void stage_rc(int b, int& R, int& C) { const int st = b / 1024, sb = b % 1024, swz = sb ^ (((sb >> 9) & 1) << 5); R = (st >> 1) * 16 + swz / 64; C = (st & 1) * 32 + (swz % 64) / 2; }
__device__ __forceinline__ int perm32(int rho) { const int n = rho >> 4, i = rho & 15; return 8 * (i >> 2) + 4 * n + (i & 3); }

struct Unit { int pm, pn; long aoff, boff; int nt, seg; };
struct Gemm { const bf16_t* A; const bf16_t* Bt; int lda, K; };

__device__ __forceinline__ void static_unit(int nM, int nN, int L, Unit& u, const int WGM = 4) {
    const int nwg = nM * nN; int wgid = L;
    { const int q = nwg / NXCD, r = nwg % NXCD, xcd = wgid % NXCD, off = wgid / NXCD; wgid = (xcd < r ? xcd * (q + 1) : r * (q + 1) + (xcd - r) * q) + off; }
    const int nig = WGM * nN, gid = wgid / nig, fm = gid * WGM, gsz = (nM - fm) < WGM ? (nM - fm) : WGM;
    u.pm = fm + ((wgid % nig) % gsz); u.pn = (wgid % nig) / gsz; u.aoff = 0; u.boff = 0; u.nt = 0; u.seg = 2;
}
struct StaticOrder {
    int nM, nN, nwg, G, c, wgm;
    __device__ void init(int M, int N, int G_, int c_, int wgm_ = 4) { nM = M / BM; nN = N / BM; nwg = nM * nN; G = G_; c = c_; wgm = wgm_; }
    __device__ __forceinline__ bool next(int i, Unit& u) const { const long L = (long)i * G + c; if (L >= nwg) return false; static_unit(nM, nN, (int)L, u, wgm); return true; }
};
struct Order1 {
    int G, c;
    __device__ __forceinline__ bool next(int i, Unit& u) const { const long L = (long)i * G + c; constexpr int NMAIN = 160 * 12;
        if (L < NMAIN) { static_unit(160, 12, (int)L, u); return true; }
        if (L < NMAIN + 12) { const int r = (int)L - NMAIN; u.pm = 160 + r / 4; u.pn = 36 + r % 4; u.aoff = 0; u.boff = 0; u.nt = 0; u.seg = 2; return true; }
        return false; }
};
struct Order23 {
    int G, c;
    __device__ __forceinline__ bool next(int i, Unit& u) const { const long L = (long)i * G + c; if (L >= 160 * 11) return false; static_unit(160, 11, (int)L, u); u.aoff = (u.pn < 5) ? 0 : 512 * 2; return true; }
};

struct OrderMerge {
    int G, c;
    __device__ __forceinline__ bool next(int i, Unit& u) const { const int ti = i / 3, seg = i - 3 * ti; const long L = (long)ti * G + c; if (L >= 160 * 8) return false;
        static_unit(160, 8, (int)L, u); const int k0 = seg * 768; u.aoff = k0 * 2; u.boff = k0 * 2; u.nt = seg == 2 ? 8 : 12; u.seg = seg; return true; }
};
typedef long i64x2 __attribute__((ext_vector_type(2)));
template <class Epi, class Sched, bool F8 = false>
__device__ __forceinline__ void gemm_phase(LAS unsigned char* lds, const Gemm g, const Sched& S, const Epi& E) {
    int tid = threadIdx.x; asm volatile("" : "+v"(tid));
    const int wid = __builtin_amdgcn_readfirstlane(tid >> 6), lane = tid & 63, wr = wid >> 2, wc = wid & 3, fr = lane & 15, fq = lane >> 4;
    const int K = g.K, lda = g.lda;
    unsigned voffA[2], voffB[2];
#pragma unroll
    for (int i = 0; i < 2; ++i) { int R, C; stage_rc(tid * 16 + i * 8192, R, C); const int Rb = (R & ~31) + perm32(R & 31);
        voffA[i] = (unsigned)(R * lda + C) * 2u; voffB[i] = (unsigned)(Rb * K + C) * 2u; }
    const size_t kstep = (size_t)(BK * 2);
    const size_t hstepA = (size_t)HALF * lda * 2, hstepB = (size_t)HALF * K * 2;
    const size_t tstepA = 2 * hstepA, tstepB = 2 * hstepB;
    const unsigned ldsw = (unsigned)wid * 1024u;
    const int aoff = lds_byte(wr * 64 + fr, fq * 8), boff = lds_byte(wc * 32 + fr, fq * 8);
#define PG8_SA(b, h) (((b) * 2 + (h)) * HTB)
#define PG8_SB(b, h) ((4 + (b) * 2 + (h)) * HTB)
#define PG8_STAGE(bufoff, gbase, voff) do { _Pragma("unroll") for (int _i = 0; _i < 2; ++_i) \
        __builtin_amdgcn_global_load_lds((const unsigned*)((const char*)(gbase) + (voff)[_i]), (LAS unsigned*)(lds + (bufoff) + ldsw + _i * 8192), 16, 0, 0); } while (0)
#define PG8_LDA(dst, b, h) do { _Pragma("unroll") for (int m = 0; m < 4; ++m) _Pragma("unroll") for (int k = 0; k < 2; ++k) dst[m][k] = *(const LAS bf16x8*)(lds + PG8_SA(b, h) + aoff + m * 2048 + k * 1024); } while (0)
#define PG8_LDB(dst, b, h) do { _Pragma("unroll") for (int n = 0; n < 2; ++n) _Pragma("unroll") for (int k = 0; k < 2; ++k) dst[n][k] = *(const LAS bf16x8*)(lds + PG8_SB(b, h) + boff + n * 2048 + k * 1024); } while (0)
#define PG8_MMA(ai, bj, At, Bt) do { __builtin_amdgcn_s_setprio(1); _Pragma("unroll") for (int m = 0; m < 4; ++m) _Pragma("unroll") for (int n = 0; n < 2; ++n) _Pragma("unroll") for (int k = 0; k < 2; ++k) { \
        if constexpr (F8) { const i64x2 b_ = __builtin_bit_cast(i64x2, Bt[n][k]), a_ = __builtin_bit_cast(i64x2, At[m][k]); \
            acc[ai][bj][m][n] = __builtin_amdgcn_mfma_f32_16x16x32_fp8_fp8(b_[0], a_[0], acc[ai][bj][m][n], 0, 0, 0); acc[ai][bj][m][n] = __builtin_amdgcn_mfma_f32_16x16x32_fp8_fp8(b_[1], a_[1], acc[ai][bj][m][n], 0, 0, 0); } \
        else acc[ai][bj][m][n] = __builtin_amdgcn_mfma_f32_16x16x32_bf16(Bt[n][k], At[m][k], acc[ai][bj][m][n], 0, 0, 0); } \
        __builtin_amdgcn_s_setprio(0); } while (0)
#define PG8_WAIT_V(n) asm volatile("s_waitcnt vmcnt(" #n ")" ::: "memory")
#define PG8_WAIT_L(n) asm volatile("s_waitcnt lgkmcnt(" #n ")" ::: "memory")
#define PG8_BAR __builtin_amdgcn_s_barrier()
#define PG8_SCHED __builtin_amdgcn_sched_barrier(0)
    Unit cur, nxt; int ui = 0;
    if (!S.next(0, cur)) return;
    f32x4 acc[2][2][4][2];
#pragma unroll
    for (int a = 0; a < 2; ++a)
#pragma unroll
        for (int b = 0; b < 2; ++b)
#pragma unroll
            for (int m = 0; m < 4; ++m)
#pragma unroll
                for (int n = 0; n < 2; ++n) acc[a][b][m][n] = (f32x4){0.f, 0.f, 0.f, 0.f};
    bf16x8 At[4][2], B0[2][2], B1[2][2];
    const char* cA = (const char*)g.A + (size_t)cur.pm * tstepA + cur.aoff; const char* cB = (const char*)g.Bt + (size_t)cur.pn * tstepB + cur.boff;
    PG8_STAGE(PG8_SB(0, 0), cB, voffB); PG8_STAGE(PG8_SB(0, 1), cB + hstepB, voffB); PG8_STAGE(PG8_SA(0, 0), cA, voffA); PG8_STAGE(PG8_SA(0, 1), cA + hstepA, voffA);
    if (wr == 1) PG8_BAR;
    PG8_WAIT_V(2); PG8_BAR;
    PG8_STAGE(PG8_SB(1, 0), cB + kstep, voffB); PG8_STAGE(PG8_SA(1, 0), cA + kstep, voffA); PG8_STAGE(PG8_SB(1, 1), cB + hstepB + kstep, voffB);
    PG8_WAIT_V(6); PG8_BAR;
    for (;;) {
        const bool has_next = S.next(ui + 1, nxt);
        const char* nA = has_next ? (const char*)g.A + (size_t)nxt.pm * tstepA + nxt.aoff : cA; const char* nB = has_next ? (const char*)g.Bt + (size_t)nxt.pn * tstepB + nxt.boff : cB;
        const int nt = cur.nt ? cur.nt : K / BK;
        for (int t = 0; t < nt; t += 2) {
            const bool last = (t == nt - 2);
            const char* a1 = cA + (size_t)(t + 1) * kstep;
            const char* a2 = last ? nA : cA + (size_t)(t + 2) * kstep; const char* b2 = last ? nB : cB + (size_t)(t + 2) * kstep;
            const char* a3 = a2 + kstep; const char* b3 = b2 + kstep;
            PG8_LDB(B0, 0, 0); PG8_LDB(B1, 0, 1); PG8_SCHED; PG8_LDA(At, 0, 0); PG8_STAGE(PG8_SA(1, 1), a1 + hstepA, voffA);
            PG8_WAIT_V(8); PG8_WAIT_L(0); PG8_BAR; PG8_MMA(0, 0, At, B0); PG8_MMA(0, 1, At, B1); PG8_BAR; PG8_SCHED;
            PG8_LDA(At, 0, 1); PG8_STAGE(PG8_SB(0, 0), b2, voffB); PG8_STAGE(PG8_SB(0, 1), b2 + hstepB, voffB); PG8_STAGE(PG8_SA(0, 0), a2, voffA);
            PG8_WAIT_V(8); PG8_WAIT_L(0); PG8_BAR; PG8_MMA(1, 0, At, B0); PG8_MMA(1, 1, At, B1); PG8_BAR; PG8_SCHED;
            PG8_LDB(B0, 1, 0); PG8_LDB(B1, 1, 1); PG8_SCHED; PG8_LDA(At, 1, 0); PG8_STAGE(PG8_SA(0, 1), a2 + hstepA, voffA);
            PG8_WAIT_V(8); PG8_WAIT_L(0); PG8_BAR; PG8_MMA(0, 0, At, B0); PG8_MMA(0, 1, At, B1); PG8_BAR; PG8_SCHED;
            PG8_LDA(At, 1, 1); PG8_STAGE(PG8_SB(1, 0), b3, voffB); PG8_STAGE(PG8_SB(1, 1), b3 + hstepB, voffB); PG8_STAGE(PG8_SA(1, 0), a3, voffA);
            PG8_WAIT_V(8); PG8_WAIT_L(0); PG8_BAR; PG8_MMA(1, 0, At, B0); PG8_MMA(1, 1, At, B1); PG8_BAR; PG8_SCHED;
        }
        if (wr == 0) PG8_BAR;
        E(acc, cur, wr, wc, fr, fq);
        if (!has_next) break;
        if (!(Epi::HAS_HOOK && cur.seg != 2)) {
#pragma unroll
        for (int a = 0; a < 2; ++a)
#pragma unroll
            for (int b = 0; b < 2; ++b)
#pragma unroll
                for (int m = 0; m < 4; ++m)
#pragma unroll
                    for (int n = 0; n < 2; ++n) acc[a][b][m][n] = (f32x4){0.f, 0.f, 0.f, 0.f};
        }
        cur = nxt; cA = nA; cB = nB; ++ui;
        if (wr == 1) PG8_BAR;
    }
    PG8_WAIT_V(0);
    PG8_BAR;
#undef PG8_SA
#undef PG8_SB
#undef PG8_STAGE
#undef PG8_LDA
#undef PG8_LDB
#undef PG8_MMA
#undef PG8_WAIT_V
#undef PG8_WAIT_L
#undef PG8_BAR
#undef PG8_SCHED
}

typedef f32x4 Acc[2][2][4][2];
#define EPI_LOOP_ROWS  _Pragma("unroll") for (int ai = 0; ai < 2; ++ai) _Pragma("unroll") for (int m = 0; m < 4; ++m)
__device__ __forceinline__ u32x4 pack8(f32x4 v0, f32x4 v1) { u32x4 w; w.x = cvt_pk_bf16(v0[0], v0[1]); w.y = cvt_pk_bf16(v0[2], v0[3]); w.z = cvt_pk_bf16(v1[0], v1[1]); w.w = cvt_pk_bf16(v1[2], v1[3]); return w; }

struct EpiProj {
    static constexpr bool HAS_HOOK = false;
    bf16_t* proj; bf16_t* gates; bf16_t* mkv; const float* bgate;
    __device__ __forceinline__ void operator()(const Acc& acc, const Unit& u, int wr, int wc, int fr, int fq) const {
        bf16_t* base; int ld, colt, rowt; bool act = false;
        if (u.pn < 12) { base = proj; ld = NPROJ; colt = u.pn * 256; rowt = u.pm * 256; }
        else if (u.pn < 36) { base = gates; ld = NGATE; colt = (u.pn - 12) * 256; rowt = u.pm * 256; act = true; }
        else { base = mkv; ld = NMKV; colt = (u.pn - 36) * 256; rowt = (u.pm - 160) * 256; }
        const int col0 = colt + wc * 32 + 8 * fq;
        f32x4 bv[2][2];
#pragma unroll
        for (int bj = 0; bj < 2; ++bj)
#pragma unroll
            for (int n = 0; n < 2; ++n) bv[bj][n] = act ? *(const f32x4*)(bgate + col0 + bj * HALF + 4 * n) : (f32x4){0.f, 0.f, 0.f, 0.f};
        EPI_LOOP_ROWS { bf16_t* rowp = base + (size_t)(rowt + ai * HALF + wr * 64 + m * 16 + fr) * ld + col0;
#pragma unroll
            for (int bj = 0; bj < 2; ++bj) { f32x4 v0 = acc[ai][bj][m][0] + bv[bj][0], v1 = acc[ai][bj][m][1] + bv[bj][1];
                if (act) {
#pragma unroll
                    for (int e = 0; e < 4; ++e) { v0[e] = sigmoidf_(v0[e]); v1[e] = sigmoidf_(v1[e]); } }
                *(u32x4*)(rowp + bj * HALF) = pack8(v0, v1); } }
    }
};
struct EpiGate {
    static constexpr bool HAS_HOOK = false;
    bf16_t* gates; const float* bgate;
    __device__ __forceinline__ void operator()(const Acc& acc, const Unit& u, int wr, int wc, int fr, int fq) const {
        const int col0 = u.pn * 256 + wc * 32 + 8 * fq;
        EPI_LOOP_ROWS { bf16_t* rowp = gates + (size_t)(u.pm * 256 + ai * HALF + wr * 64 + m * 16 + fr) * NGATE + col0;
#pragma unroll
            for (int bj = 0; bj < 2; ++bj) { f32x4 v0 = acc[ai][bj][m][0] * 0.015625f + *(const f32x4*)(bgate + col0 + bj * HALF), v1 = acc[ai][bj][m][1] * 0.015625f + *(const f32x4*)(bgate + col0 + bj * HALF + 4);
#pragma unroll
                for (int e = 0; e < 4; ++e) { v0[e] = sigmoidf_(v0[e]); v1[e] = sigmoidf_(v1[e]); }
                *(u32x4*)(rowp + bj * HALF) = pack8(v0, v1); } }
    }
};
struct EpiLat {
    static constexpr bool HAS_HOOK = false;
    bf16_t* qb; bf16_t* kvb; const float* rstd;
    LAS unsigned char* ldsx; unsigned char* vt;
    __device__ __forceinline__ void operator()(const Acc& acc, const Unit& u, int wr, int wc, int fr, int fq) const {
        bf16_t* base; int ld, colt, which;
        if (u.pn < 5) { base = qb; ld = LDQB; colt = u.pn * 256; which = 0; } else { base = kvb; ld = LDKVB; colt = (u.pn - 5) * 256; which = 1; }
        const int col0 = colt + wc * 32 + 8 * fq;
        EPI_LOOP_ROWS { const int row = u.pm * 256 + ai * HALF + wr * 64 + m * 16 + fr; const float s = rstd[row * 2 + which]; bf16_t* rowp = base + (size_t)row * ld + col0;
            if (which == 0) {
#pragma unroll
                for (int bj = 0; bj < 2; ++bj) *(u32x4*)(rowp + bj * HALF) = pack8(acc[ai][bj][m][0] * s, acc[ai][bj][m][1] * s);
            } else {
                const f32x4 k0 = acc[ai][0][m][0] * s, k1 = acc[ai][0][m][1] * s;
                u32x2 w; w.x = pk4_fp8(k0[0], k0[1], k0[2], k0[3]); w.y = pk4_fp8(k1[0], k1[1], k1[2], k1[3]);
                *(u32x2*)((char*)kvb + (size_t)row * (LDKVB * 2) + (size_t)(u.pn - 5) * 512 + wc * 32 + 8 * fq) = w;
                const f32x4 v0 = acc[ai][1][m][0] * s, v1 = acc[ai][1][m][1] * s; const unsigned q0 = pk4_fp8(v0[0], v0[1], v0[2], v0[3]), q1 = pk4_fp8(v1[0], v1[1], v1[2], v1[3]);
                LAS unsigned char* sp = ldsx + 131072 + (wr * 4 + wc) * 2048 + (8 * fq) * 64 + 16 * m + fr;
                sp[0 * 64] = (unsigned char)(q0); sp[1 * 64] = (unsigned char)(q0 >> 8); sp[2 * 64] = (unsigned char)(q0 >> 16); sp[3 * 64] = (unsigned char)(q0 >> 24);
                sp[4 * 64] = (unsigned char)(q1); sp[5 * 64] = (unsigned char)(q1 >> 8); sp[6 * 64] = (unsigned char)(q1 >> 16); sp[7 * 64] = (unsigned char)(q1 >> 24);
                if (m == 3) {
                    asm volatile("s_waitcnt lgkmcnt(0)" ::: "memory");
                    const int pm = u.pm, sq = pm < 64 ? 0 : (pm < 128 ? 1 : 2), slen = sq < 2 ? SEQ_P : SEQ_S, pos0 = pm * 256 - (sq < 2 ? sq * SEQ_P : T_PROMPT);
                    unsigned char* vth = vt + (size_t)sq * (6 * 128 * SEQ_P) + (size_t)(u.pn - 5) * 128 * slen;
                    const int lane_ = fq * 16 + fr; LAS unsigned char* wb = ldsx + 131072 + (wr * 4 + wc) * 2048;
#pragma unroll
                    for (int c2 = 0; c2 < 2; ++c2) { const int id = lane_ + 64 * c2, col = id >> 2, seg = id & 3;
                        const u32x4 vv = *(const LAS u32x4*)(wb + col * 64 + seg * 16);
                        *(u32x4*)(vth + (size_t)(32 * wc + col) * slen + pos0 + ai * HALF + wr * 64 + seg * 16) = vv; }
                    asm volatile("s_waitcnt lgkmcnt(0)" ::: "memory");
                }
            } }
    }
};
struct EpiMerge {
    static constexpr bool HAS_HOOK = false;
    bf16_t* X; const bf16_t* gates; int br;
    __device__ __forceinline__ void operator()(const Acc& acc, const Unit& u, int wr, int wc, int fr, int fq) const {
        const int col0 = u.pn * 256 + wc * 32 + 8 * fq;
        EPI_LOOP_ROWS { const int row = u.pm * 256 + ai * HALF + wr * 64 + m * 16 + fr;
#pragma unroll
            for (int bj = 0; bj < 2; ++bj) { const int col = col0 + bj * HALF;
                const u32x4 gv = *(const u32x4*)(gates + (size_t)row * NGATE + br * DM + col);
                f32x4 p0 = (f32x4){0.f, 0.f, 0.f, 0.f}, p1 = p0;
                if (br) { const u32x4 pv = *(const u32x4*)(X + (size_t)row * DM + col); p0 = (f32x4){bf_lo(pv.x), bf_hi(pv.x), bf_lo(pv.y), bf_hi(pv.y)}; p1 = (f32x4){bf_lo(pv.z), bf_hi(pv.z), bf_lo(pv.w), bf_hi(pv.w)}; }
                const f32x4 g0 = (f32x4){bf_lo(gv.x), bf_hi(gv.x), bf_lo(gv.y), bf_hi(gv.y)}, g1 = (f32x4){bf_lo(gv.z), bf_hi(gv.z), bf_lo(gv.w), bf_hi(gv.w)};
                *(u32x4*)(X + (size_t)row * DM + col) = pack8(p0 + g0 * acc[ai][bj][m][0], p1 + g1 * acc[ai][bj][m][1]); } }
    }
};
struct EpiMergeF {
    static constexpr bool HAS_HOOK = true;
    bf16_t* X; const bf16_t* gates;
    __device__ __forceinline__ void operator()(Acc& acc, const Unit& u, int wr, int wc, int fr, int fq) const {
        const int seg = u.seg; const bool fin = seg == 2;
        unsigned off = (unsigned)(((u.pm * 256 + wr * 64 + fr) * NGATE + u.pn * 256 + wc * 32 + 8 * fq + seg * DM) * 2);
        const unsigned doff = fin ? 0u : (unsigned)(DM * 2);
        asm volatile("" : "+v"(off));
        const char* gb = (const char*)gates;
#pragma unroll
        for (int ai = 0; ai < 2; ++ai)
#pragma unroll
            for (int mp = 0; mp < 4; mp += HOOKB) {
                u32x4 gn[HOOKB][2], gd[HOOKB][2];
#pragma unroll
                for (int mm = 0; mm < HOOKB; ++mm)
#pragma unroll
                    for (int bj = 0; bj < 2; ++bj) { const unsigned o = off + (unsigned)(((ai * HALF + (mp + mm) * 16) * NGATE + bj * HALF) * 2);
                        gn[mm][bj] = *(const u32x4*)(gb + o); gd[mm][bj] = *(const u32x4*)(gb + o + doff); }
#pragma unroll
                for (int mm = 0; mm < HOOKB; ++mm)
#pragma unroll
                    for (int bj = 0; bj < 2; ++bj) {
#pragma unroll
                        for (int e = 0; e < 4; ++e) { const float n0 = bf_lo(gn[mm][bj][e]), n1 = bf_hi(gn[mm][bj][e]), d0 = bf_lo(gd[mm][bj][e]), d1 = bf_hi(gd[mm][bj][e]);
                            const float r0 = fin ? n0 : n0 * __builtin_amdgcn_rcpf(fmaxf(d0, 1e-20f)), r1 = fin ? n1 : n1 * __builtin_amdgcn_rcpf(fmaxf(d1, 1e-20f));
                            acc[ai][bj][mp + mm][e >> 1][(e & 1) * 2] *= r0; acc[ai][bj][mp + mm][e >> 1][(e & 1) * 2 + 1] *= r1; } }
                asm volatile("" ::: "memory");
            }
        if (fin) {
            unsigned xoff = (unsigned)(((u.pm * 256 + wr * 64 + fr) * DM + u.pn * 256 + wc * 32 + 8 * fq) * 2);
            asm volatile("" : "+v"(xoff));
            char* xb = (char*)X;
            EPI_LOOP_ROWS {
#pragma unroll
                for (int bj = 0; bj < 2; ++bj) *(u32x4*)(xb + xoff + (unsigned)(((ai * HALF + m * 16) * DM + bj * HALF) * 2)) = pack8(acc[ai][bj][m][0], acc[ai][bj][m][1]); }
        }
    }
};
struct EpiResLN {
    static constexpr bool HAS_HOOK = false;
    float* out; const f32x2* stats; const float* lg; const float* lb;
    __device__ __forceinline__ void operator()(const Acc& acc, const Unit& u, int wr, int wc, int fr, int fq) const {
        const int col0 = u.pn * 256 + wc * 32 + 8 * fq;
        f32x4 gg[2][2], bb[2][2];
#pragma unroll
        for (int bj = 0; bj < 2; ++bj)
#pragma unroll
            for (int n = 0; n < 2; ++n) { gg[bj][n] = *(const f32x4*)(lg + col0 + bj * HALF + 4 * n) * ALPHA; bb[bj][n] = *(const f32x4*)(lb + col0 + bj * HALF + 4 * n) * ALPHA; }
        EPI_LOOP_ROWS { const int row = u.pm * 256 + ai * HALF + wr * 64 + m * 16 + fr; const f32x2 st = stats[row]; float* rp = out + (size_t)row * DM + col0;
#pragma unroll
            for (int bj = 0; bj < 2; ++bj) { const f32x4 r0 = *(const f32x4*)(rp + bj * HALF), r1 = *(const f32x4*)(rp + bj * HALF + 4);
                *(f32x4*)(rp + bj * HALF) = ((r0 - st.x) * st.y) * gg[bj][0] + bb[bj][0] + acc[ai][bj][m][0];
                *(f32x4*)(rp + bj * HALF + 4) = ((r1 - st.x) * st.y) * gg[bj][1] + bb[bj][1] + acc[ai][bj][m][1]; } }
    }
};
struct EpiRes {
    static constexpr bool HAS_HOOK = false;
    const float* resA; const float* resB; float* out;
    __device__ __forceinline__ void operator()(const Acc& acc, const Unit& u, int wr, int wc, int fr, int fq) const {
        const int col0 = u.pn * 256 + wc * 32 + 8 * fq;
        const float* rb = (u.pm < 128) ? resA + (size_t)u.pm * 256 * DM : resB + (size_t)(u.pm - 128) * 256 * DM;
        float* ob = out + (size_t)u.pm * 256 * DM;
        EPI_LOOP_ROWS { const size_t off = (size_t)(ai * HALF + wr * 64 + m * 16 + fr) * DM + col0;
#pragma unroll
            for (int bj = 0; bj < 2; ++bj) { const f32x4 r0 = *(const f32x4*)(rb + off + bj * HALF), r1 = *(const f32x4*)(rb + off + bj * HALF + 4);
                *(f32x4*)(ob + off + bj * HALF) = r0 * ALPHA + acc[ai][bj][m][0]; *(f32x4*)(ob + off + bj * HALF + 4) = r1 * ALPHA + acc[ai][bj][m][1]; } }
    }
};
struct EpiSwiglu {
    static constexpr bool HAS_HOOK = false;
    bf16_t* act;
    __device__ __forceinline__ void operator()(const Acc& acc, const Unit& u, int wr, int wc, int fr, int fq) const {
        const int col0 = u.pn * 128 + wc * 32 + 8 * fq;
        EPI_LOOP_ROWS { const int row = u.pm * 256 + ai * HALF + wr * 64 + m * 16 + fr;
            f32x4 g0 = acc[ai][0][m][0], g1 = acc[ai][0][m][1]; const f32x4 u0 = acc[ai][1][m][0], u1 = acc[ai][1][m][1];
#pragma unroll
            for (int e = 0; e < 4; ++e) { g0[e] = g0[e] * sigmoidf_(g0[e]) * u0[e]; g1[e] = g1[e] * sigmoidf_(g1[e]) * u1[e]; }
            *(u32x4*)(act + (size_t)row * DFF + col0) = pack8(g0, g1); }
    }
};
}

namespace att {
constexpr int NW = 8, QBLK = 32, KVBLK = 64;
constexpr int SHM_V = 16384, SHM_K = 16384, SHM_KR = 8192;
constexpr int OFF_V = 0, OFF_K = 32768, OFF_KR = 65536, OFF_WS = 81920, OFF_QR = 83968, OFF_BT = 116736, OFF_IDX = 117888, LDS_END = 117904;
#define KSWZ(row, colB) ((row) * 256 + ((colB) ^ (((row) & 7) << 4)))
#define KRSWZ(row, colB) ((row) * 128 + ((colB) ^ (((row) & 7) << 4)))
#define SBAR() __builtin_amdgcn_sched_barrier(0)
__device__ __forceinline__ int crow(int r, int hi) { return (r & 3) + 8 * (r >> 2) + 4 * hi; }
typedef __bf16 bf16x2_t __attribute__((ext_vector_type(2)));
__device__ __forceinline__ unsigned cvtpk(float lo, float hi) { f32x2 v = {lo, hi}; bf16x2_t b = __builtin_convertvector(v, bf16x2_t); return __builtin_bit_cast(unsigned, b); }
__device__ __forceinline__ bf16x8 ld8(const bf16_t* p) { return *reinterpret_cast<const bf16x8*>(p); }

template <int MODE>
__device__ __forceinline__ void partialSM(f32x16& p0, f32x16& p1, float& m_reg, float& mn, float& alpha, const float C, int kb, const float* btab, const bool nomask) {
  if constexpr (MODE == 1) {
#pragma unroll
    for (int r = 0; r < 16; ++r) { const int i0 = kb + (r & 3) + 8 * (r >> 2), i1 = i0 + 32;
      const bool v0 = nomask || (unsigned)i0 <= 256u, v1 = nomask || (unsigned)i1 <= 256u;
      const float b0 = btab[nomask ? 257 : (v0 ? i0 : 0)], b1 = btab[nomask ? 257 : (v1 ? i1 : 0)];
      p0[r] = v0 ? fmaf(p0[r], C, b0) : -1e30f; p1[r] = v1 ? fmaf(p1[r], C, b1) : -1e30f; }
    float pmax = p0[0];
#pragma unroll
    for (int r = 1; r < 16; ++r) pmax = fmaxf(pmax, p0[r]);
#pragma unroll
    for (int r = 0; r < 16; ++r) pmax = fmaxf(pmax, p1[r]);
    { auto rr = __builtin_amdgcn_permlane32_swap(__float_as_uint(pmax), __float_as_uint(pmax), false, false); pmax = fmaxf(__uint_as_float(rr[0]), __uint_as_float(rr[1])); }
    { const bool keep = __all(pmax - m_reg <= 11.5f); mn = keep ? m_reg : fmaxf(m_reg, pmax); alpha = __builtin_amdgcn_exp2f(m_reg - mn); m_reg = mn; }
#pragma unroll
    for (int r = 0; r < 16; ++r) { p0[r] -= mn; p1[r] -= mn; }
#pragma unroll
    for (int r = 0; r < 16; ++r) p0[r] = __builtin_amdgcn_exp2f(p0[r]);
  } else {
    float pmax = p0[0];
#pragma unroll
    for (int r = 1; r < 16; ++r) pmax = fmaxf(pmax, p0[r]);
#pragma unroll
    for (int r = 0; r < 16; ++r) pmax = fmaxf(pmax, p1[r]);
    { auto rr = __builtin_amdgcn_permlane32_swap(__float_as_uint(pmax), __float_as_uint(pmax), false, false); pmax = fmaxf(__uint_as_float(rr[0]), __uint_as_float(rr[1])); }
    { const bool keep = __all((pmax - m_reg) * C <= (MODE == 0 ? 7.5f : 11.5f)); mn = keep ? m_reg : fmaxf(m_reg, pmax);   alpha = __builtin_amdgcn_exp2f((m_reg - mn) * C); m_reg = mn; }
    const float mnC = -mn * C;
#pragma unroll
    for (int r = 0; r < 16; ++r) p0[r] = fmaf(p0[r], C, mnC);
#pragma unroll
    for (int r = 0; r < 16; ++r) p1[r] = fmaf(p1[r], C, mnC);
#pragma unroll
    for (int r = 0; r < 16; ++r) p0[r] = __builtin_amdgcn_exp2f(p0[r]);
  }
}
__device__ __forceinline__ void finishSM(f32x16& p0, f32x16& p1, float alpha, float& l_reg, bf16x8& pa0, bf16x8& pa1, bf16x8& pa2, bf16x8& pa3) {
#pragma unroll
  for (int r = 0; r < 16; ++r) p1[r] = __builtin_amdgcn_exp2f(p1[r]);
  float ps = 0;
#pragma unroll
  for (int r = 0; r < 16; ++r) ps += p0[r];
#pragma unroll
  for (int r = 0; r < 16; ++r) ps += p1[r];
  { auto rr = __builtin_amdgcn_permlane32_swap(__float_as_uint(ps), __float_as_uint(ps), false, false); ps = __uint_as_float(rr[0]) + __uint_as_float(rr[1]); }
  l_reg = l_reg * alpha + ps;
#define PK4(P, BASE, OUT) do { unsigned a0 = cvtpk(P[BASE + 0], P[BASE + 1]), a1 = cvtpk(P[BASE + 2], P[BASE + 3]);   \
    unsigned b0 = cvtpk(P[BASE + 4], P[BASE + 5]), b1 = cvtpk(P[BASE + 6], P[BASE + 7]);                              \
    auto r0 = __builtin_amdgcn_permlane32_swap(a0, b0, false, false); auto r1 = __builtin_amdgcn_permlane32_swap(a1, b1, false, false); \
    u32x4 w = {r0[0], r1[0], r0[1], r1[1]}; OUT = *reinterpret_cast<bf16x8*>(&w); } while (0)
  PK4(p0, 0, pa0); PK4(p0, 8, pa1); PK4(p1, 0, pa2); PK4(p1, 8, pa3);
#undef PK4
}
template <int MODE>
__device__ __forceinline__ void qkt(f32x16& p0, f32x16& p1, const char* Ks, const char* Krs, const char* Qrs, const bf16x8* qr, const i32x8* q8, int r32, int hi) {
  p0 = f32x16{}; p1 = f32x16{};
  if constexpr (MODE == 0) {
#pragma unroll
    for (int kb = 0; kb < 3; ++kb) {
#pragma unroll
      for (int hf = 0; hf < 2; ++hf) { const char* a_ = Ks + (hf * 32 + r32) * 208 + kb * 64 + hi * 32;
        const u32x4 lo = *reinterpret_cast<const u32x4*>(a_), h4 = *reinterpret_cast<const u32x4*>(a_ + 16);
        const i32x8 a = {(int)lo.x, (int)lo.y, (int)lo.z, (int)lo.w, (int)h4.x, (int)h4.y, (int)h4.z, (int)h4.w};
        if (hf) p1 = __builtin_amdgcn_mfma_scale_f32_32x32x64_f8f6f4(a, q8[kb], p1, 0, 0, 0, 0x7F7F7F7F, 0, 0x7F7F7F7F);
        else p0 = __builtin_amdgcn_mfma_scale_f32_32x32x64_f8f6f4(a, q8[kb], p0, 0, 0, 0, 0x7F7F7F7F, 0, 0x7F7F7F7F); } }
  } else {
#pragma unroll
    for (int d0 = 0; d0 < 8; ++d0) { const int cb = (d0 * 16 + hi * 8) * 2;
      const bf16x8 b0 = *reinterpret_cast<const bf16x8*>(Ks + KSWZ(r32, cb));
      const bf16x8 b1 = *reinterpret_cast<const bf16x8*>(Ks + KSWZ(32 + r32, cb));
      p0 = __builtin_amdgcn_mfma_f32_32x32x16_bf16(b0, qr[d0], p0, 0, 0, 0);
      p1 = __builtin_amdgcn_mfma_f32_32x32x16_bf16(b1, qr[d0], p1, 0, 0, 0); }
  }
}
__device__ __forceinline__ int v_st(int k, int c) { const int kk = (k & ~0xC) | ((k & 4) << 1) | ((k & 8) >> 1); return ((kk >> 3) * 4 + (c >> 5)) * 512 + ((kk & 7) * 32 + (c & 31)) * 2; }
__device__ __forceinline__ int v_rd_base(int lane) { return ((lane & 3) << 3) | (((lane >> 2) & 3) << 6) | (((lane >> 4) & 1) << 5) | (((lane >> 5) & 1) << 8); }
constexpr int v_rd_off(int d0, int ks, int half) { return d0 * 512 + ks * 4096 + half * 2048; }
typedef short v4i16_t __attribute__((ext_vector_type(4)));
template <int OFF> __device__ __forceinline__ s16x4 tr_read(int vb) {
  return __builtin_bit_cast(s16x4, __builtin_amdgcn_ds_read_tr16_b64_v4i16((__attribute__((address_space(3))) v4i16_t*)(uintptr_t)(unsigned)(vb + OFF)));
}
template <int D0> __device__ __forceinline__ void pv_one(f32x16& od, int vb, bf16x8 pa0, bf16x8 pa1, bf16x8 pa2, bf16x8 pa3) {
  const s16x4 l0 = tr_read<v_rd_off(D0, 0, 0)>(vb), h0 = tr_read<v_rd_off(D0, 0, 1)>(vb), l1 = tr_read<v_rd_off(D0, 1, 0)>(vb), h1 = tr_read<v_rd_off(D0, 1, 1)>(vb);
  const s16x4 l2 = tr_read<v_rd_off(D0, 2, 0)>(vb), h2 = tr_read<v_rd_off(D0, 2, 1)>(vb), l3 = tr_read<v_rd_off(D0, 3, 0)>(vb), h3 = tr_read<v_rd_off(D0, 3, 1)>(vb);
#define PK(L, H) (bf16x8){L[0], L[1], L[2], L[3], H[0], H[1], H[2], H[3]}
  od = __builtin_amdgcn_mfma_f32_32x32x16_bf16(pa0, PK(l0, h0), od, 0, 0, 0);
  od = __builtin_amdgcn_mfma_f32_32x32x16_bf16(pa1, PK(l1, h1), od, 0, 0, 0);
  od = __builtin_amdgcn_mfma_f32_32x32x16_bf16(pa2, PK(l2, h2), od, 0, 0, 0);
  od = __builtin_amdgcn_mfma_f32_32x32x16_bf16(pa3, PK(l3, h3), od, 0, 0, 0);
#undef PK
}
__device__ __forceinline__ void pv_d0(f32x16* o, int vb, bf16x8 pa0, bf16x8 pa1, bf16x8 pa2, bf16x8 pa3) {
  pv_one<0>(o[0], vb, pa0, pa1, pa2, pa3); pv_one<1>(o[1], vb, pa0, pa1, pa2, pa3); pv_one<2>(o[2], vb, pa0, pa1, pa2, pa3); pv_one<3>(o[3], vb, pa0, pa1, pa2, pa3);
}

__device__ __forceinline__ void finishSM8(f32x16& p0, f32x16& p1, float alpha, float& l_reg, bf16x8& pa0, bf16x8& pa1) {
#pragma unroll
  for (int r = 0; r < 16; ++r) p1[r] = __builtin_amdgcn_exp2f(p1[r]);
  float ps = 0;
#pragma unroll
  for (int r = 0; r < 16; ++r) ps += p0[r];
#pragma unroll
  for (int r = 0; r < 16; ++r) ps += p1[r];
  { auto rr = __builtin_amdgcn_permlane32_swap(__float_as_uint(ps), __float_as_uint(ps), false, false); ps = __uint_as_float(rr[0]) + __uint_as_float(rr[1]); }
  l_reg = l_reg * alpha + ps;
  const u32x4 w0 = {pk4_fp8(p0[0], p0[1], p0[2], p0[3]), pk4_fp8(p0[4], p0[5], p0[6], p0[7]), pk4_fp8(p0[8], p0[9], p0[10], p0[11]), pk4_fp8(p0[12], p0[13], p0[14], p0[15])};
  const u32x4 w1 = {pk4_fp8(p1[0], p1[1], p1[2], p1[3]), pk4_fp8(p1[4], p1[5], p1[6], p1[7]), pk4_fp8(p1[8], p1[9], p1[10], p1[11]), pk4_fp8(p1[12], p1[13], p1[14], p1[15])};
  pa0 = __builtin_bit_cast(bf16x8, w0); pa1 = __builtin_bit_cast(bf16x8, w1);
}
__device__ __forceinline__ void pv8(f32x16* o, const char* Vs, bf16x8 pa0, bf16x8 pa1, int r32, int hi) {
  const u32x4 a0 = __builtin_bit_cast(u32x4, pa0), a1 = __builtin_bit_cast(u32x4, pa1);
  const i32x8 P = {(int)a0.x, (int)a0.y, (int)a0.z, (int)a0.w, (int)a1.x, (int)a1.y, (int)a1.z, (int)a1.w};
#pragma unroll
  for (int d0 = 0; d0 < 4; ++d0) { const char* b_ = Vs + (d0 * 32 + r32) * 80 + hi * 32;
    const u32x4 lo = *reinterpret_cast<const u32x4*>(b_), h4 = *reinterpret_cast<const u32x4*>(b_ + 16);
    const i32x8 V = {(int)lo.x, (int)lo.y, (int)lo.z, (int)lo.w, (int)h4.x, (int)h4.y, (int)h4.z, (int)h4.w};
    o[d0] = __builtin_amdgcn_mfma_scale_f32_32x32x64_f8f6f4(P, V, o[d0], 0, 0, 0, 0x7F7F7F7F, 0, 0x7F7F7F7F); }
}

template <int MODE, int SD>
__device__ __forceinline__ void attn_body(const bf16_t* __restrict__ Qb, const bf16_t* __restrict__ Kh, const bf16_t* __restrict__ Vh, const bf16_t* __restrict__ Krp,
                                          bf16_t* __restrict__ Ob, int NT, const float C, const f32x2* __restrict__ cs, int kbw, float sink_l2, const bool nomask,
                                          const int LDQ, const int LDK, const int LDO, char* lds) {
  int tid = threadIdx.x; asm volatile("" : "+v"(tid));
  const int wid = tid >> 6, lane = tid & 63, r32 = lane & 31, hi = lane >> 5;
  if (ATT_PRIO && wid >= 4) __builtin_amdgcn_s_setprio(1);
  char* V_lds = lds + OFF_V; char* K_lds = lds + OFF_K; char* Kr_lds = lds + OFF_KR;
  float* ws = (float*)(lds + OFF_WS) + wid * 64; float* li_l = ws; float* al_l = ws + 32;
  char* Qr_l = lds + OFF_QR + wid * 4096;
  const float* btab = (const float*)(lds + OFF_BT);
  float m_reg = -1e30f, l_reg = 0; f32x16 o[4] = {}; bf16x8 qr[8] = {}; i32x8 q8[3] = {};
  if constexpr (MODE != 0) {
    const bf16_t* Qw = Qb + (long)(wid * QBLK + r32) * LDQ + hi * 8;
#pragma unroll
    for (int d0 = 0; d0 < 8; ++d0) qr[d0] = ld8(Qw + d0 * 16);
  } else {
    const bf16_t* Qrow = Qb + (long)(wid * QBLK + r32) * LDQ;
#define BF2F(v) __uint_as_float(((unsigned)(unsigned short)(v)) << 16)
#pragma unroll
    for (int kb = 0; kb < 2; ++kb) { unsigned w[8];
#pragma unroll
      for (int c = 0; c < 4; ++c) { const bf16x8 x = ld8(Qrow + kb * 64 + hi * 32 + c * 8);
        w[2 * c] = pk4_fp8(BF2F(x[0]), BF2F(x[1]), BF2F(x[2]), BF2F(x[3])); w[2 * c + 1] = pk4_fp8(BF2F(x[4]), BF2F(x[5]), BF2F(x[6]), BF2F(x[7])); }
      q8[kb] = (i32x8){(int)w[0], (int)w[1], (int)w[2], (int)w[3], (int)w[4], (int)w[5], (int)w[6], (int)w[7]}; }
    { const f32x2* csr = cs + (long)(wid * QBLK + r32) * 32; unsigned w[8];
#pragma unroll
      for (int c = 0; c < 4; ++c) { const bf16x8 x1 = ld8(Qrow + 128 + c * 8), x2 = ld8(Qrow + 160 + c * 8); float r[8];
#pragma unroll
        for (int e = 0; e < 8; ++e) { const f32x2 t = csr[c * 8 + e]; const float a = BF2F(x1[e]), b = BF2F(x2[e]); r[e] = hi ? (b * t.x + a * t.y) : (a * t.x - b * t.y); }
        w[2 * c] = pk4_fp8(r[0], r[1], r[2], r[3]); w[2 * c + 1] = pk4_fp8(r[4], r[5], r[6], r[7]); }
      q8[2] = (i32x8){(int)w[0], (int)w[1], (int)w[2], (int)w[3], (int)w[4], (int)w[5], (int)w[6], (int)w[7]}; }
#undef BF2F
  }
  const int sr = tid >> 4, sc = (tid & 15) * 8, vst0 = v_st(sr, sc), vst1 = v_st(32 + sr, sc);
  const int krr = tid >> 3, krc = (tid & 7) * 8;
  const int kr0 = tid / 12, kc0 = tid - kr0 * 12, kr1 = (512 + tid) / 12, kc1 = (512 + tid) - kr1 * 12;
#define KAPPA(rho) ((((rho) >> 2) & 1) * 32 + (((rho) >> 5) & 1) * 16 + (((rho) & 3) | ((((rho) >> 3) & 3) << 2)))
  const int ks0r = KAPPA(kr0), ks1r = KAPPA(kr1), vd = tid >> 2, vch = tid & 3;
  const int vb0 = (int)(uintptr_t)V_lds + v_rd_base(lane);
  struct { bf16x8 vs0, vs1, ks0, ks1; } sr_[SD];
#define K8SRC(r_, c_, k0) ((c_) < 8 ? (const char*)Kh + (long)((k0) + (r_)) * 3072 + (c_) * 16 : (const char*)Krp + (long)((k0) + (r_)) * 64 + ((c_) - 8) * 16)
#define SLOAD(i, k0) do { \
    if constexpr (MODE == 0) { sr_[i].vs0 = *reinterpret_cast<const bf16x8*>((const char*)Vh + (long)vd * LDK + (k0) + vch * 16); \
      sr_[i].ks0 = *reinterpret_cast<const bf16x8*>(K8SRC(ks0r, kc0, k0)); if (tid < 256) sr_[i].ks1 = *reinterpret_cast<const bf16x8*>(K8SRC(ks1r, kc1, k0)); } \
    else { sr_[i].vs0 = ld8(&Vh[(long)((k0) + sr) * LDK + sc]); sr_[i].vs1 = ld8(&Vh[(long)((k0) + 32 + sr) * LDK + sc]); \
      sr_[i].ks0 = ld8(&Kh[(long)((k0) + sr) * LDK + sc]); sr_[i].ks1 = ld8(&Kh[(long)((k0) + 32 + sr) * LDK + sc]); } } while (0)
#define SWRITE(b, i) do { const int kc = sc * 2; \
    if constexpr (MODE == 0) { *(bf16x8*)(V_lds + (b) * SHM_V + vd * 80 + vch * 16) = sr_[i].vs0; \
      *(bf16x8*)(K_lds + (b) * SHM_K + kr0 * 208 + kc0 * 16) = sr_[i].ks0; if (tid < 256) *(bf16x8*)(K_lds + (b) * SHM_K + kr1 * 208 + kc1 * 16) = sr_[i].ks1; } \
    else { *(bf16x8*)(V_lds + (b) * SHM_V + vst0) = sr_[i].vs0; *(bf16x8*)(V_lds + (b) * SHM_V + vst1) = sr_[i].vs1; \
      *(bf16x8*)(K_lds + (b) * SHM_K + KSWZ(sr, kc)) = sr_[i].ks0; *(bf16x8*)(K_lds + (b) * SHM_K + KSWZ(32 + sr, kc)) = sr_[i].ks1; } } while (0)
#define PVC(voff) do { if constexpr (MODE == 0) pv8(o, V_lds + (voff), pa0, pa1, r32, hi); else pv_d0(o, vb0 + (voff), pa0, pa1, pa2, pa3); } while (0)
#define FSM(P0, P1, AL) do { if constexpr (MODE == 0) finishSM8(P0, P1, AL, l_reg, pa0, pa1); else finishSM(P0, P1, AL, l_reg, pa0, pa1, pa2, pa3); } while (0)
#define SWAIT() do { if constexpr (SD == 1) asm volatile("s_waitcnt vmcnt(0)" ::: "memory"); else if constexpr (MODE == 0) asm volatile("s_waitcnt vmcnt(5)" ::: "memory"); else asm volatile("s_waitcnt vmcnt(4)" ::: "memory"); } while (0)
#define SG_ONE(nds, nv, nt) do { __builtin_amdgcn_sched_group_barrier(0x008, 1, 0); __builtin_amdgcn_sched_group_barrier(0x100, nds, 0); \
    __builtin_amdgcn_sched_group_barrier(0x002, nv, 0); __builtin_amdgcn_sched_group_barrier(0x400, nt, 0); } while (0)
#define SG_QKT() do { if (SGQ) { __builtin_amdgcn_sched_group_barrier(0x100, SGQ_PRE, 0); if constexpr (MODE == 0) { _Pragma("unroll") for (int _g = 0; _g < 6; ++_g) SG_ONE(2, 12, 3); } else { _Pragma("unroll") for (int _g = 0; _g < 16; ++_g) SG_ONE(1, 5, 1); } } } while (0)
#define SG_PV() do { if (SGP) { __builtin_amdgcn_sched_group_barrier(0x100, SGP_PRE, 0); if constexpr (MODE == 0) { _Pragma("unroll") for (int _g = 0; _g < 4; ++_g) SG_ONE(2, 24, 4); } else { _Pragma("unroll") for (int _g = 0; _g < 16; ++_g) SG_ONE(2, 6, 1); } } } while (0)
#define RESC(a) do { if (__any((a) < 1.f)) { if (hi == 0) al_l[r32] = (a); asm volatile("s_waitcnt lgkmcnt(0)" ::: "memory"); \
    _Pragma("unroll") for (int d = 0; d < 4; ++d) _Pragma("unroll") for (int r = 0; r < 16; ++r) o[d][r] *= al_l[crow(r, hi)]; } } while (0)
  f32x16 pA0, pA1, pB0, pB1; float mnA, mnB, alA, alB; bf16x8 pa0, pa1, pa2 = {}, pa3 = {};
  const int kbl = kbw - wid * QBLK - r32 + 4 * hi;
  constexpr int SE = 0, SO = SD - 1;
  SLOAD(SE, 0); asm volatile("s_waitcnt vmcnt(0)" ::: "memory"); SWRITE(0, SE); __syncthreads();
  qkt<MODE>(pA0, pA1, K_lds, Kr_lds, Qr_l, qr, q8, r32, hi); partialSM<MODE>(pA0, pA1, m_reg, mnA, alA, C, kbl, btab, nomask);
  SLOAD(SO, KVBLK); if constexpr (SD == 2) { if (2 < NT) SLOAD(SE, 2 * KVBLK); }
  SWAIT(); SWRITE(1, SO); __syncthreads();
  for (int j = 1; j + 1 < NT; j += 2) {
    SBAR(); qkt<MODE>(pB0, pB1, K_lds + SHM_K, Kr_lds + SHM_KR, Qr_l, qr, q8, r32, hi);
    FSM(pA0, pA1, alA); SG_QKT(); SBAR();
    SLOAD(SO, (j + SD) * KVBLK); SBAR();
    PVC(0); partialSM<MODE>(pB0, pB1, m_reg, mnB, alB, C, kbl + j * KVBLK, btab, nomask); asm volatile("" : "+v"(pB0), "+v"(pB1), "+v"(alB)); SG_PV(); SBAR();
    __syncthreads(); SWAIT(); SWRITE(0, SE);
    RESC(alB); __syncthreads();
    SBAR(); qkt<MODE>(pA0, pA1, K_lds, Kr_lds, Qr_l, qr, q8, r32, hi);
    FSM(pB0, pB1, alB); SG_QKT(); SBAR();
    if (SD == 1 || j + 3 < NT) SLOAD(SE, (j + 1 + SD) * KVBLK); SBAR();
    PVC(SHM_V); partialSM<MODE>(pA0, pA1, m_reg, mnA, alA, C, kbl + (j + 1) * KVBLK, btab, nomask); asm volatile("" : "+v"(pA0), "+v"(pA1), "+v"(alA)); SG_PV(); SBAR();
    __syncthreads(); SWAIT(); SWRITE(1, SO);
    RESC(alA); __syncthreads();
  }
  SBAR(); qkt<MODE>(pB0, pB1, K_lds + SHM_K, Kr_lds + SHM_KR, Qr_l, qr, q8, r32, hi);
  FSM(pA0, pA1, alA); SBAR();
  PVC(0); partialSM<MODE>(pB0, pB1, m_reg, mnB, alB, C, kbl + (NT - 1) * KVBLK, btab, nomask);
  __syncthreads(); RESC(alB);
  FSM(pB0, pB1, alB); SBAR();
  PVC(SHM_V);
  if constexpr (MODE == 1) l_reg += __builtin_amdgcn_exp2f(sink_l2 - m_reg);
  if (hi == 0) li_l[r32] = l_reg; asm volatile("s_waitcnt lgkmcnt(0)" ::: "memory");
  float rli[16];
#pragma unroll
  for (int r = 0; r < 16; ++r) rli[r] = __builtin_amdgcn_rcpf(li_l[crow(r, hi)]);
  bf16_t* Ow = Ob + (long)(wid * QBLK) * LDO;
#pragma unroll
  for (int r = 0; r < 16; ++r) { const int orow = crow(r, hi);
#pragma unroll
    for (int d0 = 0; d0 < 4; ++d0) Ow[(long)orow * LDO + d0 * 32 + r32] = (bf16_t)(cvtpk(o[d0][r] * rli[r], 0.f) & 0xffffu); }
  if (ATT_PRIO) __builtin_amdgcn_s_setprio(0);
#undef SG_ONE
#undef SG_QKT
#undef SG_PV
#undef SLOAD
#undef K8SRC
#undef KAPPA
#undef PVC
#undef FSM
#undef SWRITE
#undef SWAIT
#undef RESC
}
}

#define RLX_AGENT __ATOMIC_RELAXED, __HIP_MEMORY_SCOPE_AGENT
#define XB_TMO      128
#define XB_XCNT(j)  (256  + 64 * (j))
#define XB_XSUB(j)  (1280 + 64 * (j))
#define XB_XGEN(j)  (2304 + 64 * (j))
#define XB_TOP      3328
#define XB_TOPGEN   3392
#define XCD_BAR_WORDS 3456
#define XB_SPIN_CAP (1u << 18)

__device__ __forceinline__ unsigned xb_ld(unsigned* p)              { return __hip_atomic_load(p, __ATOMIC_RELAXED, __HIP_MEMORY_SCOPE_AGENT); }
__device__ __forceinline__ unsigned xb_add(unsigned* p, unsigned v) { return __hip_atomic_fetch_add(p, v, __ATOMIC_RELAXED, __HIP_MEMORY_SCOPE_AGENT); }
__device__ __forceinline__ unsigned xb_xcc_id() { return (unsigned)__builtin_amdgcn_s_getreg((3 << 11) | 20) & 0xFu; }
#define XB_SPIN(cond, bar) do { unsigned _sp = 0; while (cond) { __builtin_amdgcn_s_sleep(1); \
    if ((++_sp & 255u) == 0u) { if (xb_ld(&(bar)[XB_TMO])) break; if (_sp > XB_SPIN_CAP) { atomicAdd(&(bar)[XB_TMO], 1u); break; } } } } while (0)

struct XcdBarrier {
    unsigned* bar; unsigned x;
    volatile LAS unsigned* st;
};

__device__ __forceinline__ XcdBarrier xcd_barrier_post(unsigned* bar, volatile LAS unsigned* st) {
    XcdBarrier b; b.bar = bar; b.x = xb_xcc_id(); b.st = st;
    if (threadIdx.x == 0) (void)xb_add(&bar[XB_XCNT(b.x)], 1u);
    return b;
}
__device__ __forceinline__ void xcd_barrier_complete(unsigned* bar, unsigned x, unsigned& nloc, unsigned& nx) {
    const unsigned G = gridDim.x * gridDim.y * gridDim.z;
    unsigned sum, cnt, mine, sp = 0u;
    for (;;) {
        sum = 0u; cnt = 0u; mine = 0u;
#pragma unroll
        for (unsigned j = 0; j < 16; ++j) { const unsigned c = xb_ld(&bar[XB_XCNT(j)]); sum += c; cnt += (c > 0u) ? 1u : 0u; mine = (j == x) ? c : mine; }
        if (sum == G) break;
        __builtin_amdgcn_s_sleep(1);
        if ((++sp & 255u) == 0u) { if (xb_ld(&bar[XB_TMO])) break; if (sp > XB_SPIN_CAP) { atomicAdd(&bar[XB_TMO], 1u); break; } }
    }
    nloc = mine > 0u ? mine : 1u; nx = cnt > 0u ? cnt : 1u;
}

__device__ __forceinline__ void xcd_barrier(const XcdBarrier& b) {
    asm volatile("s_waitcnt vmcnt(0)" ::: "memory");
    __syncthreads();
    if (threadIdx.x == 0) {
        unsigned* bar = b.bar;
        __builtin_amdgcn_s_waitcnt(0);
        unsigned nloc = b.st[0], nx = b.st[1];
        if (nloc == 0u) { xcd_barrier_complete(bar, b.x, nloc, nx); b.st[0] = nloc; b.st[1] = nx; }
        const unsigned old = xb_add(&bar[XB_XSUB(b.x)], 1u);
        const unsigned gen = old / nloc;
        if (old + 1u == (gen + 1u) * nloc) {
            __builtin_amdgcn_fence(__ATOMIC_RELEASE, "agent");
            asm volatile("s_waitcnt vmcnt(0)" ::: "memory");
            const unsigned og = xb_add(&bar[XB_TOP], 1u);
            const unsigned tg = og / nx;
            if (og + 1u == (tg + 1u) * nx) xb_add(&bar[XB_TOPGEN], 1u);
            else XB_SPIN(xb_ld(&bar[XB_TOPGEN]) == tg, bar);
            __builtin_amdgcn_fence(__ATOMIC_ACQUIRE, "agent");
            xb_add(&bar[XB_XGEN(b.x)], 1u);
            asm volatile("s_waitcnt vmcnt(0)" ::: "memory");
        } else {
            XB_SPIN(xb_ld(&bar[XB_XGEN(b.x)]) == gen, bar);
            __builtin_amdgcn_fence(__ATOMIC_ACQUIRE, "agent");
            asm volatile("s_waitcnt vmcnt(0)" ::: "memory");
        }
    }
    __syncthreads();
}


struct Args {
    const float* in[24];
    float* out; unsigned char* ws;
    float inv_freq[32];
    int never, pad;
};

__device__ __forceinline__ float wave_sum(float v) {
#pragma unroll
    for (int o = 1; o < 64; o <<= 1) v += __shfl_xor(v, o);
    return v;
}
__device__ __forceinline__ unsigned f2bf(float f) { unsigned u = __builtin_bit_cast(unsigned, f); return (u + 0x7fffu + ((u >> 16) & 1u)) >> 16; }
__device__ __forceinline__ unsigned pk2(float lo, float hi) { return f2bf(lo) | (f2bf(hi) << 16); }

template <bool F8 = false>
__device__ __forceinline__ void tr_item(const float* __restrict__ W, int K, int N, bf16_t* __restrict__ WT, int dst_row, int k0, int n0, LAS float* scr, int lane, const float* __restrict__ ksc, int ldt = 0, int koff = 0) {
    if (ldt == 0) ldt = K;
    {
        float v[32];
#pragma unroll
        for (int i = 0; i < 32; ++i) v[i] = W[(size_t)(k0 + 2 * i + (lane >> 5)) * N + n0 + (lane & 31)];
        if (ksc) {
#pragma unroll
            for (int i = 0; i < 32; ++i) v[i] *= ksc[k0 + 2 * i + (lane >> 5)];
        }
#pragma unroll
        for (int i = 0; i < 32; ++i) scr[(2 * i + (lane >> 5)) * 33 + (lane & 31)] = v[i];
    }
    asm volatile("s_waitcnt lgkmcnt(0)" ::: "memory");
    const int c = lane & 7;
#pragma unroll
    for (int j = 0; j < 4; ++j) { const int n = (lane >> 3) + 8 * j; const LAS float* s = scr + (8 * c) * 33 + n;
        if constexpr (F8) { u32x2 o8; o8.x = pk4_fp8(s[0 * 33] * 64.f, s[1 * 33] * 64.f, s[2 * 33] * 64.f, s[3 * 33] * 64.f); o8.y = pk4_fp8(s[4 * 33] * 64.f, s[5 * 33] * 64.f, s[6 * 33] * 64.f, s[7 * 33] * 64.f);
            *(u32x2*)((unsigned char*)WT + (size_t)(dst_row + n) * ldt + koff + k0 + 8 * c) = o8; }
        else { u32x4 o; o.x = pk2(s[0 * 33], s[1 * 33]); o.y = pk2(s[2 * 33], s[3 * 33]); o.z = pk2(s[4 * 33], s[5 * 33]); o.w = pk2(s[6 * 33], s[7 * 33]);
            *(u32x4*)(WT + (size_t)(dst_row + n) * ldt + koff + k0 + 8 * c) = o; } }
    asm volatile("s_waitcnt lgkmcnt(0)" ::: "memory");
}

template <bool STATS>
__device__ __forceinline__ void ln_row(const float* xin, float* xout, bf16_t* bout, const float* __restrict__ g, const float* __restrict__ b, int lane, f32x2* st) {
    f32x4 v[8]; float s = 0.f;
#pragma unroll
    for (int j = 0; j < 8; ++j) { v[j] = *(const f32x4*)(xin + (lane + 64 * j) * 4); s += (v[j].x + v[j].y) + (v[j].z + v[j].w); }
    const float mean = wave_sum(s) * (1.f / DM); float s2 = 0.f;
#pragma unroll
    for (int j = 0; j < 8; ++j) { v[j] = v[j] - mean; s2 += (v[j].x * v[j].x + v[j].y * v[j].y) + (v[j].z * v[j].z + v[j].w * v[j].w); }
    const float rstd = 1.f / sqrtf(wave_sum(s2) * (1.f / DM) + 1e-5f);
    if constexpr (STATS) { if (lane == 0) *st = (f32x2){mean, rstd}; }
#pragma unroll
    for (int j = 0; j < 8; ++j) { const int c = (lane + 64 * j) * 4; const f32x4 gg = *(const f32x4*)(g + c), bb = *(const f32x4*)(b + c);
        const f32x4 o = v[j] * rstd * gg + bb;
        if constexpr (STATS) { u32x2 w; w.x = cvt_pk_bf16(o.x, o.y); w.y = cvt_pk_bf16(o.z, o.w); *(u32x2*)(bout + c) = w; }
        else *(f32x4*)(xout + c) = o; }
}

constexpr int LDS_BYTES = 148480;
constexpr int N_ATT_UNITS = 768 + 192 + 960 + 640;

__global__ void __launch_bounds__(512) fwd_megakernel(Args args) {
    extern __shared__ __attribute__((aligned(16))) unsigned char lds_raw[];
    cg::grid_group grid = cg::this_grid();
    LAS unsigned char* lds = (LAS unsigned char*)lds_raw;
    const int tid = threadIdx.x, lane = tid & 63, wave = __builtin_amdgcn_readfirstlane(tid >> 6);
    const int G = gridDim.x, bx = blockIdx.x;
#define ws (args.ws)
#define x_prompt (args.in[0])
#define x_sample (args.in[1])
#define W1T ((bf16_t*)(ws + WS_W1T))
#define WLAT ((bf16_t*)(ws + WS_WLAT))
#define WBA ((bf16_t*)(ws + WS_WBA))
#define WBB ((bf16_t*)(ws + WS_WBB))
#define WBC ((bf16_t*)(ws + WS_WBC))
#define WOT ((bf16_t*)(ws + WS_WO))
#define WFI ((bf16_t*)(ws + WS_WFI))
#define WFD ((bf16_t*)(ws + WS_WFD))
#define ROPE ((f32x2*)(ws + WS_ROPE))
#define MKV ((bf16_t*)(ws + WS_MKV))
#define RSTD ((float*)(ws + WS_RSTD))
#define KROPE ((bf16_t*)(ws + WS_KROPE))
#define XB ((bf16_t*)(ws + WS_R1))
#define AOUT ((bf16_t*)(ws + WS_R1 + R1_AOUT))
#define BOUT ((bf16_t*)(ws + WS_R1 + R1_BOUT))
#define COUT ((bf16_t*)(ws + WS_R1 + R1_COUT))
#define HB XB
#define GATES ((bf16_t*)(ws + WS_R2))
#define ACT GATES
#define QB ((bf16_t*)(ws + WS_R3 + R3_QB))
#define KVB ((bf16_t*)(ws + WS_R3 + R3_KVB))
#define XM ((bf16_t*)(ws + WS_R3))
#define PROJ ((bf16_t*)args.out)
#define OUT (args.out)
#define CTL ((unsigned*)(ws + WS_CTL))
    const int gw = bx * 8 + wave, NGW = G * 8;
    volatile LAS unsigned* MISC = (volatile LAS unsigned*)(lds + (LDS_BYTES - 64));
    if (tid < 16) MISC[tid] = 0u;
    __syncthreads();
    XcdBarrier xbar = xcd_barrier_post(CTL + 4096, MISC + 8);

    {
        LAS float* scr = (LAS float*)(lds + wave * 16384);
        constexpr int I0 = 32 * 90, I1 = 32 * 192, I2 = 32 * 32, I3 = 8 * 36, I4 = 8 * 48, I5 = 12 * 64, I6 = 12 * 64, I7 = 8 * 64, I8 = 32 * 64, I9 = 32 * 352, I10 = 88 * 64;
        constexpr int NIT = I0 + I1 + I2 + I3 + I4 + I5 + I6 + I7 + I8 + I9 + I10;
        for (int it = gw; it < NIT; it += NGW) {
            int r = it;
            if (r < I0) { const int kb = r / 90, nb = r % 90, n0 = nb * 32; const int dst = n0 < 2304 ? n0 : (n0 < 2368 ? n0 + 512 : n0 - 64);
                tr_item(args.in[4], 2048, 2880, W1T, dst, kb * 64, n0, scr, lane, nullptr); continue; } r -= I0;
            if (r < I1) { const int kb = r / 192, nb = r % 192; tr_item<true>(args.in[12], 2048, 6144, W1T + (size_t)NPROJ * DM  , nb * 32, kb * 64, nb * 32, scr, lane, nullptr); continue; } r -= I1;
            if (r < I2) { const int kb = r / 32, nb = r % 32; tr_item(args.in[11], 2048, 1024, W1T, NPROJ + NGATE + nb * 32, kb * 64, nb * 32, scr, lane, nullptr); continue; } r -= I2;
            if (r < I3) { const int kb = r / 36, nb = r % 36; tr_item(args.in[8], 512, 1152, WLAT, nb * 32, kb * 64, nb * 32, scr, lane, args.in[7]); continue; } r -= I3;
            if (r < I4) { const int kb = r / 48, nb = r % 48; tr_item(args.in[10], 512, 1536, WLAT, LDQB + nb * 32, kb * 64, nb * 32, scr, lane, args.in[9]); continue; } r -= I4;
            if (r < I5) { const int kb = r / 64, nb = r % 64; tr_item(args.in[14], 768, 2048, WBA, nb * 32, kb * 64, nb * 32, scr, lane, nullptr, DM, 0); continue; } r -= I5;
            if (r < I6) { const int kb = r / 64, nb = r % 64; tr_item(args.in[15], 768, 2048, WBA, nb * 32, kb * 64, nb * 32, scr, lane, nullptr, DM, 768); continue; } r -= I6;
            if (r < I7) { const int kb = r / 64, nb = r % 64; tr_item(args.in[16], 512, 2048, WBA, nb * 32, kb * 64, nb * 32, scr, lane, nullptr, DM, 1536); continue; } r -= I7;
            if (r < I8) { const int kb = r / 64, nb = r % 64; tr_item(args.in[17], 2048, 2048, WOT, nb * 32, kb * 64, nb * 32, scr, lane, nullptr); continue; } r -= I8;
            if (r < I9) { const int kb = r / 352, nb = r % 352, n0 = nb * 32; const int j = n0 < DFF ? n0 : n0 - DFF; const int dst = (j / 128) * 256 + (n0 < DFF ? 0 : 128) + (j % 128);
                tr_item(args.in[20], 2048, 2 * DFF, WFI, dst, kb * 64, n0, scr, lane, nullptr); continue; } r -= I9;
            { const int kb = r / 64, nb = r % 64; tr_item(args.in[21], DFF, 2048, WFD, nb * 32, kb * 64, nb * 32, scr, lane, nullptr); }
        }
        const long gt = (long)bx * 512 + tid, NGT = (long)G * 512;
        constexpr long NX8 = (long)(T_TOK + 768) * DM / 8;
        for (long i = gt; i < NX8; i += NGT) { const long e = i * 8; const float* src;
            if (e < (long)T_PROMPT * DM) src = x_prompt + e; else if (e < (long)T_TOK * DM) src = x_sample + (e - (long)T_PROMPT * DM);
            else if (e < (long)(T_TOK + 512) * DM) src = args.in[2] + (e - (long)T_TOK * DM); else src = args.in[3] + (e - (long)(T_TOK + 512) * DM);
            const f32x4 a = *(const f32x4*)src, b = *(const f32x4*)(src + 4);
            *(u32x4*)(XB + e) = pg8::pack8(a, b);
            if (e < (long)T_TOK * DM) { u32x2 o8; o8.x = pk4_fp8(a[0], a[1], a[2], a[3]); o8.y = pk4_fp8(b[0], b[1], b[2], b[3]); *(u32x2*)((unsigned char*)(ws + WS_R3) + e) = o8; } }
        for (long i = gt; i < (long)SEQ_P * 32; i += NGT) { const int pos = (int)(i >> 5), j = (int)(i & 31);
            const float ang = (float)pos * args.inv_freq[j];
            const double rev = (double)ang * 0.15915494309189535; const float fr = (float)(rev - floor(rev));
            ROPE[i] = (f32x2){__builtin_amdgcn_cosf(fr), __builtin_amdgcn_sinf(fr)}; }
    }
    if (args.never) grid.sync();
    xcd_barrier(xbar);

    for (int rep = 0; rep < REP_SYNC; ++rep) xcd_barrier(xbar);
    {
        pg8::Gemm g{XB, W1T, DM, DM}; pg8::Order1 S{G, bx};
        pg8::EpiProj E{PROJ, GATES, MKV, args.in[13]};
        pg8::gemm_phase<pg8::EpiProj, pg8::Order1>(lds, g, S, E);
    }
    {
        pg8::Gemm g8{(const bf16_t*)(ws + WS_R3), W1T + (size_t)NPROJ * DM, DM / 2, DM / 2}; pg8::StaticOrder S8; S8.init(T_TOK, NGATE, G, bx);
        pg8::EpiGate E8{GATES, args.in[13]};
        pg8::gemm_phase<pg8::EpiGate, pg8::StaticOrder, true>(lds, g8, S8, E8);
    }
    xcd_barrier(xbar);

    for (int m0 = gw * P2R; m0 < T_TOK; m0 += NGW * P2R) {
        u32x4 a[P2R], b[P2R]; float x1[P2R], x2[P2R]; f32x2 cs4[P2R];
#pragma unroll
        for (int i = 0; i < P2R; ++i) { const int m = m0 + i; const bf16_t* pr = PROJ + (size_t)m * NPROJ;
            a[i] = *(const u32x4*)(pr + C_CQ + lane * 8); b[i] = *(const u32x4*)(pr + C_CKV + lane * 8);
            const int pos = m < T_PROMPT ? (m & (SEQ_P - 1)) : (m - T_PROMPT);
            x1[i] = bf_lo((unsigned)pr[C_KR + (lane & 31)]); x2[i] = bf_lo((unsigned)pr[C_KR + 32 + (lane & 31)]); cs4[i] = ROPE[(size_t)pos * 32 + (lane & 31)]; }
#pragma unroll
        for (int i = 0; i < P2R; ++i) { const int m = m0 + i; float sa = 0.f, sb = 0.f;
#pragma unroll
            for (int e = 0; e < 4; ++e) { const float a0 = bf_lo(a[i][e]), a1 = bf_hi(a[i][e]), b0 = bf_lo(b[i][e]), b1 = bf_hi(b[i][e]); sa += a0 * a0 + a1 * a1; sb += b0 * b0 + b1 * b1; }
            sa = wave_sum(sa); sb = wave_sum(sb);
            if (lane == 0) { RSTD[m * 2] = 1.f / sqrtf(sa * (1.f / 512.f) + 1e-6f); RSTD[m * 2 + 1] = 1.f / sqrtf(sb * (1.f / 512.f) + 1e-6f); }
            if (lane < 32) { const float r1 = x1[i] * cs4[i].x - x2[i] * cs4[i].y, r2 = x2[i] * cs4[i].x + x1[i] * cs4[i].y; const unsigned pk = pk4_fp8(r1, r2, 0.f, 0.f);
                unsigned char* kr8 = (unsigned char*)KROPE + (size_t)m * 64; kr8[lane] = (unsigned char)(pk & 0xffu); kr8[32 + lane] = (unsigned char)((pk >> 8) & 0xffu); } }
    }
    xcd_barrier(xbar);

    {
        pg8::Gemm g{PROJ + C_CQ, WLAT, NPROJ, 512}; pg8::Order23 S{G, bx};
        pg8::EpiLat E{QB, KVB, RSTD, lds, (unsigned char*)args.out + (size_t)T_TOK * NPROJ * 2  };
        pg8::gemm_phase<pg8::EpiLat, pg8::Order23>(lds, g, S, E);
    }
    xcd_barrier(xbar);

    {
        char* shm = (char*)lds_raw;
        volatile unsigned* idxw = (volatile unsigned*)(shm + att::OFF_IDX);
        float* btab = (float*)(shm + att::OFF_BT);
        for (int rep = 0; rep < REP_ATT; ++rep)
        for (;;) {
            __syncthreads();
            if (tid == 0) *idxw = atomicAdd(CTL + 64 + 64 * rep, 1u);
            __syncthreads();
            const int u = (int)*idxw;
            if (u >= N_ATT_UNITS) break;
            if (u < 960) {
                int sq, h, qb, len, rowbase;
                if (u < 768) { sq = u / 384; const int rem = u % 384; h = rem / 64; qb = rem % 64; len = SEQ_P; rowbase = sq * SEQ_P; }
                else { const int v = u - 768; h = v / 32; qb = v % 32; len = SEQ_S; rowbase = T_PROMPT; }
                const long q0 = (long)rowbase + qb * 256;
                att::attn_body<0, 1>(QB + q0 * LDQB + h * 192, (const bf16_t*)((const char*)KVB + (long)rowbase * (LDKVB * 2) + h * 512)  , (const bf16_t*)((const char*)args.out + (size_t)T_TOK * NPROJ * 2 + (size_t)(rowbase / SEQ_P) * (6 * 128 * SEQ_P) + (size_t)h * 128 * len)  , (const bf16_t*)((const char*)KROPE + (long)rowbase * 64)  ,
                                     AOUT + q0 * DM + 768 + h * 128, len / 64, 0.07216878364870322f * LOG2E, ROPE + (long)qb * 256 * 32, 0, 0.f, false, LDQB, len, DM, shm);
            } else {
                const bf16_t *Qp, *Kp, *Vp; bf16_t* Op; int NT, kbw, ldk, ldo; float sink; bool nomask;
                if (u < 1920) {
                    const int v = u - 960, t256 = v / 6, h = v % 6, kvh = h / 3;
                    const long q0 = (long)t256 * 256;
                    const int rowbase = q0 < T_PROMPT ? (int)(q0 & ~(long)(SEQ_P - 1)) : T_PROMPT; const int len = q0 < T_PROMPT ? SEQ_P : SEQ_S;
                    const int ql = (int)(q0 - rowbase);
                    const int ks = ql - 128 < 0 ? 0 : ql - 128; const int ke = ql + 384 > len ? len : ql + 384;
                    if (tid < 257) { const int rel = tid - 128; const int n = rel < 0 ? -rel : rel;
                        const int large = 8 + (n >= 12) + (n >= 16) + (n >= 23) + (n >= 32) + (n >= 46) + (n >= 64) + (n >= 91);
                        const int bucket = (rel > 0 ? 16 : 0) + (n < 8 ? n : large);
                        btab[tid] = args.in[5][bucket * 6 + h] * LOG2E; }
                    const long k0 = (long)rowbase + ks;
                    Qp = PROJ + q0 * NPROJ + C_QA + h * 128; Kp = PROJ + k0 * NPROJ + C_KA + kvh * 128; Vp = PROJ + k0 * NPROJ + C_VA + kvh * 128; Op = AOUT + q0 * DM + h * 128;
                    NT = (ke - ks) / 64; kbw = ks - ql + 128; ldk = NPROJ; ldo = DM; sink = args.in[6][h] * LOG2E; nomask = false;
                } else {
                    const int v = u - 1920, t256 = v / 4, h = v % 4;
                    const long q0 = (long)t256 * 256;
                    const int bi = q0 < T_PROMPT ? (int)(q0 / SEQ_P) : 2;
                    if (tid == 0) btab[257] = 0.f;
                    Qp = PROJ + q0 * NPROJ + C_QC + h * 128; Kp = MKV + (long)bi * 256 * NMKV + h * 128; Vp = Kp + 512; Op = AOUT + q0 * DM + 1536 + h * 128;
                    NT = 4; kbw = 0; ldk = NMKV; ldo = DM; sink = -1e30f; nomask = true;
                }
                att::attn_body<1, 1>(Qp, Kp, Vp, nullptr, Op, NT, 0.08838834764831845f * LOG2E, nullptr, kbw, sink, nomask, NPROJ, ldk, ldo, shm);
            }
        }
    }
    xcd_barrier(xbar);

    {
        pg8::StaticOrder S; S.init(T_TOK, DM, G, bx);
        { pg8::Gemm g{AOUT, WBA, DM, DM}; pg8::OrderMerge SM{G, bx}; pg8::EpiMergeF E{XM, GATES}; pg8::gemm_phase<pg8::EpiMergeF, pg8::OrderMerge>(lds, g, SM, E); }
        xcd_barrier(xbar);
        { pg8::Gemm g{XM, WOT, DM, DM}; pg8::EpiRes E{x_prompt, x_sample, OUT}; pg8::gemm_phase<pg8::EpiRes, pg8::StaticOrder>(lds, g, S, E); }
    }
    xcd_barrier(xbar);
    { int t2 = threadIdx.x; asm volatile("" : "+v"(t2)); const int lane2 = t2 & 63;
      for (int m = gw; m < T_TOK; m += NGW) ln_row<true>(OUT + (size_t)m * DM, nullptr, HB + (size_t)m * DM, args.in[18], args.in[19], lane2, (f32x2*)RSTD + m); }
    xcd_barrier(xbar);
    {
        pg8::StaticOrder S; S.init(T_TOK, 2 * DFF, G, bx, 8);
        pg8::Gemm g{HB, WFI, DM, DM}; pg8::EpiSwiglu E{ACT}; for (int rep = 0; rep < REP_FFI; ++rep) pg8::gemm_phase<pg8::EpiSwiglu, pg8::StaticOrder>(lds, g, S, E);
    }
    xcd_barrier(xbar);
    {
        pg8::StaticOrder S; S.init(T_TOK, DM, G, bx, 2);
        pg8::Gemm g{ACT, WFD, DFF, DFF}; pg8::EpiResLN E{OUT, (const f32x2*)RSTD, args.in[18], args.in[19]}; pg8::gemm_phase<pg8::EpiResLN, pg8::StaticOrder>(lds, g, S, E);
    }
    xcd_barrier(xbar);
    { int t2 = threadIdx.x; asm volatile("" : "+v"(t2)); const int lane2 = t2 & 63;
      for (int m = gw; m < T_TOK; m += NGW) ln_row<false>(OUT + (size_t)m * DM, OUT + (size_t)m * DM, nullptr, args.in[22], args.in[23], lane2, nullptr); }
}

#undef ws
#undef x_prompt
#undef x_sample
#undef W1T
#undef WLAT
#undef WBA
#undef WBB
#undef WBC
#undef WOT
#undef WFI
#undef WFD
#undef ROPE
#undef MKV
#undef RSTD
#undef KROPE
#undef XB
#undef AOUT
#undef BOUT
#undef COUT
#undef HB
#undef GATES
#undef ACT
#undef QB
#undef KVB
#undef XM
#undef PROJ
#undef OUT
#undef CTL

extern "C" void kernel_launch(void* const* d_in, const int* in_sizes, int n_in, void* d_out, int out_size, void* d_ws, size_t ws_size, hipStream_t stream) {
    static int grid = 0;
    if (grid == 0) {
        if (n_in != 24 || out_size != T_TOK * DM || ws_size < WS_END) { fprintf(stderr, "kernel_launch: unexpected shapes (n_in %d out %d ws %zu)\n", n_in, out_size, ws_size); grid = -1; return; }
        int dev = 0, cus = 0, per_cu = 0;
        hipGetDevice(&dev); hipDeviceGetAttribute(&cus, hipDeviceAttributeMultiprocessorCount, dev);
        if (hipFuncSetAttribute((const void*)fwd_megakernel, hipFuncAttributeMaxDynamicSharedMemorySize, LDS_BYTES) != hipSuccess) { fprintf(stderr, "kernel_launch: hipFuncSetAttribute failed\n"); grid = -1; return; }
        if (hipOccupancyMaxActiveBlocksPerMultiprocessor(&per_cu, (const void*)fwd_megakernel, 512, LDS_BYTES) != hipSuccess || per_cu < 1) { fprintf(stderr, "kernel_launch: occupancy query says %d\n", per_cu); per_cu = 1; }
        (void)hipGetLastError();
        grid = cus;
    }
    if (grid < 0) return;
    hipMemsetAsync((char*)d_ws + WS_CTL, 0, 65536, stream);
    Args a{};
    for (int i = 0; i < 24; ++i) a.in[i] = (const float*)d_in[i];
    a.out = (float*)d_out; a.ws = (unsigned char*)d_ws;
    for (int j = 0; j < 32; ++j) { const float e = (float)j / 32.0f; const float p = powf(10000.0f, e); a.inv_freq[j] = 1.0f / p; }
    void* kargs[] = {&a};
    hipError_t e = hipLaunchCooperativeKernel((const void*)fwd_megakernel, dim3(grid), dim3(512), kargs, LDS_BYTES, stream);
    if (e != hipSuccess) fprintf(stderr, "cooperative launch failed: %s (grid %d)\n", hipGetErrorString(e), grid);
}
```
